# Optimizing an MI355X kernel written in HIP

```python
import jax, jax.numpy as jnp
from jax import lax
import numpy as np

D_MODEL = 1024
BATCH = 8
SEQ = 4096
DEPTH = 1

N_META = 16
BLOCK = 128
META_PAD = BLOCK - N_META
HEAD_DIM = 64
SB_HEADS = (D_MODEL // 2) // HEAD_DIM
RWKV_HEADS = (D_MODEL // 2) // HEAD_DIM
SB_WIDTH = SB_HEADS * HEAD_DIM
RWKV_WIDTH = RWKV_HEADS * HEAD_DIM
MIX_WIDTH = SB_WIDTH + RWKV_WIDTH
D_FF = 2816
W_LORA = 32
A_LORA = 32
G_LORA = 96
N_RWKV_COLS = 3 * RWKV_WIDTH + W_LORA + A_LORA + G_LORA
IN_COLS = 3 * SB_WIDTH + N_RWKV_COLS
RMS_EPS = 1e-6
LNX_EPS = 64e-5

kernel_name = "hymba_sb_rwkv7_macaron"


def rms_norm(x, g):
    xf = x.astype(jnp.float32)
    y = xf * lax.rsqrt(jnp.mean(xf * xf, axis=-1, keepdims=True) + RMS_EPS)
    return (y * g.astype(jnp.float32)).astype(x.dtype)


def swiglu(h, w_gate, w_up, w_down):
    return (jax.nn.silu(h @ w_gate) * (h @ w_up)) @ w_down


def stick_breaking_attention(q, k, v):
    B, L, H, Dh = q.shape
    pad = ((0, 0), (META_PAD, 0), (0, 0), (0, 0))
    q, k, v = [jnp.pad(t, pad).transpose(0, 2, 1, 3) for t in (q, k, v)]
    Lp = L + META_PAD
    nblk = Lp // BLOCK
    key_pos = jnp.arange(Lp)
    scale = Dh ** -0.5
    qb = q.reshape(B, H, nblk, BLOCK, Dh).transpose(2, 0, 1, 3, 4)

    def block(args):
        q_blk, i = args
        q_pos = i * BLOCK + jnp.arange(BLOCK)
        z = jnp.einsum('bhqd,bhkd->bhqk', q_blk, k).astype(jnp.float32) * scale
        valid = (key_pos[None, :] < q_pos[:, None]) & (key_pos[None, :] >= META_PAD)
        log_keep = jnp.where(valid, -jax.nn.softplus(z), 0.0)
        log_rest = lax.cumsum(log_keep, axis=3, reverse=True) - log_keep
        attn = jnp.where(valid, jnp.exp(jax.nn.log_sigmoid(z) + log_rest), 0.0)
        return jnp.einsum('bhqk,bhkd->bhqd', attn.astype(v.dtype), v)

    out = lax.map(block, (qb, jnp.arange(nblk)))
    out = out.transpose(1, 0, 3, 2, 4).reshape(B, Lp, H * Dh)
    return out[:, META_PAD:]


def rwkv7_time_mix(p, mu, w0, w_up, a0, a_up, g_up, k_k, k_a, r_k, lnx_w, lnx_b):
    B, L, _ = p.shape
    C, H, N = RWKV_WIDTH, RWKV_HEADS, HEAD_DIM
    p_prev = jnp.pad(p, ((0, 0), (1, 0), (0, 0)))[:, :-1]
    p = p + (p_prev - p) * mu
    r = p[..., :C]
    k = p[..., C:2 * C]
    v = p[..., 2 * C:3 * C]
    xw = p[..., 3 * C:3 * C + W_LORA]
    xa = p[..., 3 * C + W_LORA:3 * C + W_LORA + A_LORA]
    xg = p[..., 3 * C + W_LORA + A_LORA:]
    w = -jax.nn.softplus(-(w0 + jnp.tanh(xw) @ w_up)) - 0.5
    decay = jnp.exp(-jnp.exp(w.astype(jnp.float32)))
    a = jax.nn.sigmoid(a0 + xa @ a_up)
    g = jax.nn.sigmoid(xg) @ g_up
    kk = (k * k_k).astype(jnp.float32).reshape(B, L, H, N)
    kk = kk / jnp.maximum(jnp.sqrt(jnp.sum(kk * kk, axis=-1, keepdims=True)), 1e-12)
    k = k * (1.0 + (a - 1.0) * k_a)

    rh, kh, vh, ah, dh = [t.astype(jnp.float32).reshape(B, L, H, N) for t in (r, k, v, a, decay)]

    def step(S, inp):
        r_t, w_t, k_t, v_t, kk_t, a_t = inp
        sa = jnp.einsum('bhij,bhj->bhi', S, -kk_t)
        S = (S * w_t[:, :, None, :] + sa[..., None] * (kk_t * a_t)[:, :, None, :]
             + v_t[..., None] * k_t[:, :, None, :])
        return S, jnp.einsum('bhij,bhj->bhi', S, r_t)

    xs = tuple(t.transpose(1, 0, 2, 3) for t in (rh, dh, kh, vh, kk, ah))
    S0 = jnp.zeros((B, H, N, N), jnp.float32)
    _, ys = lax.scan(step, S0, xs)
    y = ys.transpose(1, 0, 2, 3)
    mean = jnp.mean(y, axis=-1, keepdims=True)
    var = jnp.mean(jnp.square(y - mean), axis=-1, keepdims=True)
    y = ((y - mean) * lax.rsqrt(var + LNX_EPS)).reshape(B, L, C)
    y = y * lnx_w.astype(jnp.float32) + lnx_b.astype(jnp.float32)
    bonus = jnp.sum(rh * kh * r_k.astype(jnp.float32), axis=-1, keepdims=True) * vh
    y = y + bonus.reshape(B, L, C)
    return (y * g.astype(jnp.float32)).astype(p.dtype)


def setup_inputs(seed: int = 0) -> dict:
    key = jax.random.key(seed)
    ks = jax.random.split(key, 32)
    nrm = lambda k, s: jax.random.normal(k, s, jnp.float32)
    gain = lambda k, s: 1.0 + 0.02 * nrm(k, s)
    Dd = DEPTH
    return {
        "x": nrm(ks[0], (BATCH, SEQ, D_MODEL)),
        "meta_tokens": nrm(ks[1], (N_META, D_MODEL)),
        "ffn1_norm": gain(ks[2], (Dd, D_MODEL)),
        "ffn1_w_gate": nrm(ks[3], (Dd, D_MODEL, D_FF)) * D_MODEL ** -0.5,
        "ffn1_w_up": nrm(ks[4], (Dd, D_MODEL, D_FF)) * D_MODEL ** -0.5,
        "ffn1_w_down": nrm(ks[5], (Dd, D_FF, D_MODEL)) * D_FF ** -0.5,
        "mix_norm": gain(ks[6], (Dd, D_MODEL)),
        "w_in": nrm(ks[7], (Dd, D_MODEL, IN_COLS)) * D_MODEL ** -0.5,
        "rwkv_mu": jax.random.uniform(ks[8], (Dd, N_RWKV_COLS), jnp.float32),
        "rwkv_w0": jax.random.uniform(ks[9], (Dd, RWKV_WIDTH), jnp.float32, -4.0, 1.0),
        "rwkv_w_up": nrm(ks[10], (Dd, W_LORA, RWKV_WIDTH)) * 0.5 * W_LORA ** -0.5,
        "rwkv_a0": 0.5 * nrm(ks[11], (Dd, RWKV_WIDTH)),
        "rwkv_a_up": nrm(ks[12], (Dd, A_LORA, RWKV_WIDTH)) * 0.5 * A_LORA ** -0.5,
        "rwkv_g_up": nrm(ks[13], (Dd, G_LORA, RWKV_WIDTH)) * G_LORA ** -0.5,
        "rwkv_k_k": 0.85 + 0.05 * nrm(ks[14], (Dd, RWKV_WIDTH)),
        "rwkv_k_a": 1.0 + 0.05 * nrm(ks[15], (Dd, RWKV_WIDTH)),
        "rwkv_r_k": 0.1 * nrm(ks[16], (Dd, RWKV_HEADS, HEAD_DIM)),
        "rwkv_lnx_w": gain(ks[17], (Dd, RWKV_WIDTH)),
        "rwkv_lnx_b": 0.02 * nrm(ks[18], (Dd, RWKV_WIDTH)),
        "w_out": nrm(ks[19], (Dd, MIX_WIDTH, D_MODEL)) * MIX_WIDTH ** -0.5,
        "ffn2_norm": gain(ks[20], (Dd, D_MODEL)),
        "ffn2_w_gate": nrm(ks[21], (Dd, D_MODEL, D_FF)) * D_MODEL ** -0.5,
        "ffn2_w_up": nrm(ks[22], (Dd, D_MODEL, D_FF)) * D_MODEL ** -0.5,
        "ffn2_w_down": nrm(ks[23], (Dd, D_FF, D_MODEL)) * D_FF ** -0.5,
        "final_norm": gain(ks[24], (D_MODEL,)),
    }


def reference(x, meta_tokens, ffn1_norm, ffn1_w_gate, ffn1_w_up, ffn1_w_down, mix_norm, w_in,
              rwkv_mu, rwkv_w0, rwkv_w_up, rwkv_a0, rwkv_a_up, rwkv_g_up, rwkv_k_k, rwkv_k_a,
              rwkv_r_k, rwkv_lnx_w, rwkv_lnx_b, w_out, ffn2_norm, ffn2_w_gate, ffn2_w_up,
              ffn2_w_down, final_norm):
    B = x.shape[0]
    meta = jnp.broadcast_to(meta_tokens[None].astype(x.dtype), (B, N_META, D_MODEL))
    h = jnp.concatenate([meta, x], axis=1)
    for l in range(DEPTH):
        n = rms_norm(h, ffn1_norm[l])
        h = h + 0.5 * swiglu(n, ffn1_w_gate[l], ffn1_w_up[l], ffn1_w_down[l])
        n = rms_norm(h, mix_norm[l])
        proj = n @ w_in[l]
        Bn, L, _ = proj.shape
        q = proj[..., :SB_WIDTH].reshape(Bn, L, SB_HEADS, HEAD_DIM)
        k = proj[..., SB_WIDTH:2 * SB_WIDTH].reshape(Bn, L, SB_HEADS, HEAD_DIM)
        v = proj[..., 2 * SB_WIDTH:3 * SB_WIDTH].reshape(Bn, L, SB_HEADS, HEAD_DIM)
        sb_out = stick_breaking_attention(q, k, v)
        rw_out = rwkv7_time_mix(proj[..., 3 * SB_WIDTH:], rwkv_mu[l], rwkv_w0[l], rwkv_w_up[l],
                                rwkv_a0[l], rwkv_a_up[l], rwkv_g_up[l], rwkv_k_k[l], rwkv_k_a[l],
                                rwkv_r_k[l], rwkv_lnx_w[l], rwkv_lnx_b[l])
        h = h + jnp.concatenate([sb_out, rw_out], axis=-1) @ w_out[l]
        n = rms_norm(h, ffn2_norm[l])
        h = h + 0.5 * swiglu(n, ffn2_w_gate[l], ffn2_w_up[l], ffn2_w_down[l])
    return rms_norm(h, final_norm)[:, N_META:]
```

```cpp
#include <hip/hip_runtime.h>
#include <hip/hip_cooperative_groups.h>
#include <cstdio>
#include <cstdint>
namespace cg = cooperative_groups;
namespace pg8 {
#define PG8_LAS __attribute__((address_space(3)))
typedef unsigned short bf16_t;
typedef short bf16x8 __attribute__((ext_vector_type(8)));
typedef float f32x4 __attribute__((ext_vector_type(4)));
typedef unsigned u32x4 __attribute__((ext_vector_type(4)));
constexpr int BM = 256, BK = 64, HALF = 128, HTB = HALF * BK * 2  , STAGE_BYTES = 8 * HTB, NXCD = 8, WGM = 8;

__host__ __device__ __forceinline__ int lds_byte(int r, int c) { const int st = (r >> 4) * 2 + (c >> 5), rr = r & 15, cc = c & 31, ob = rr * 64 + cc * 2; return st * 1024 + (ob ^ (((ob >> 9) & 1) << 5)); }
__host__ __device__ __forceinline__ void stage_rc(int b, int& R, int& C) { const int st = b / 1024, sb = b % 1024, swz = sb ^ (((sb >> 9) & 1) << 5); R = (st >> 1) * 16 + swz / 64; C = (st & 1) * 32 + (swz % 64) / 2; }
__host__ __device__ __forceinline__ int perm32(int rho) { const int n = rho >> 4, i = rho & 15; return 8 * (i >> 2) + 4 * n + (i & 3); }

struct Unit { int pm, pn; };
struct Gemm { const bf16_t* A; const bf16_t* Bt; int M, N, K; };

struct StaticOrder {
    int nM, nN, nwg, G, c;
    __host__ __device__ void init(int M, int N, int G_, int c_) { nM = M / BM; nN = N / BM; nwg = nM * nN; G = G_; c = c_; }
    __host__ __device__ bool next(int i, Unit& u) const {
        const long L = (long)i * G + c; if (L >= nwg) return false;
        int wgid = (int)L; { const int q = nwg / NXCD, r = nwg % NXCD, xcd = wgid % NXCD, off = wgid / NXCD; wgid = (xcd < r ? xcd * (q + 1) : r * (q + 1) + (xcd - r) * q) + off; }
        const int nig = WGM * nN, gid = wgid / nig, fm = gid * WGM, gsz = (nM - fm) < WGM ? (nM - fm) : WGM;
        u.pm = fm + ((wgid % nig) % gsz); u.pn = (wgid % nig) / gsz; return true;
    }
    __device__ __forceinline__ void a_ready(const Unit&) const {}
    __device__ __forceinline__ void done(const Unit&) const {}
};

__device__ __forceinline__ unsigned cvt_pk_bf16(float lo, float hi) { unsigned r; asm volatile("v_cvt_pk_bf16_f32 %0, %1, %2" : "=v"(r) : "v"(lo), "v"(hi)); return r; }
typedef float f32x2 __attribute__((ext_vector_type(2)));

typedef unsigned u32x2 __attribute__((ext_vector_type(2)));
__device__ __forceinline__ float sum_xor16_32(float x) {
    unsigned u = __builtin_bit_cast(unsigned, x);
    const auto r = __builtin_amdgcn_permlane16_swap(u, u, false, false);
    x = __builtin_bit_cast(float, (unsigned)r[0]) + __builtin_bit_cast(float, (unsigned)r[1]);
    u = __builtin_bit_cast(unsigned, x);
    const auto t = __builtin_amdgcn_permlane32_swap(u, u, false, false);
    return __builtin_bit_cast(float, (unsigned)t[0]) + __builtin_bit_cast(float, (unsigned)t[1]);
}
__device__ __forceinline__ float rstd_of(float ss) { return __builtin_amdgcn_rsqf(ss * (1.0f / 1024.0f) + 1e-6f); }

struct EpiSwiglu {
    static constexpr bool PERM = true, AFTER_DRAIN = false;
    const float* ss; bf16_t* O;
    __device__ __forceinline__ void operator()(const f32x4 (&acc)[2][2][4][2], const Unit& u, int wr, int wc, int fr, int fq) const {
#pragma unroll
        for (int ai = 0; ai < 2; ++ai)
#pragma unroll
            for (int m = 0; m < 4; ++m) {
                const int row = u.pm * BM + ai * HALF + wr * 64 + m * 16 + fr;
                const float rs = rstd_of(ss[row]);
                unsigned w[4];
                const float rl = rs * -1.4426950408889634f, rs2 = rs * rs;
#pragma unroll
                for (int n = 0; n < 2; ++n) {
                    const f32x4 g = acc[ai][0][m][n], gu = acc[ai][0][m][n] * acc[ai][1][m][n];
                    float a[4];
#pragma unroll
                    for (int i = 0; i < 4; ++i) a[i] = gu[i] * (rs2 * __builtin_amdgcn_rcpf(1.0f + __builtin_amdgcn_exp2f(g[i] * rl)));
                    w[2 * n] = cvt_pk_bf16(a[0], a[1]); w[2 * n + 1] = cvt_pk_bf16(a[2], a[3]);
                }
                u32x4 o; o.x = w[0]; o.y = w[1]; o.z = w[2]; o.w = w[3];
                *(u32x4*)(O + (size_t)row * 2816 + u.pn * 128 + wc * 32 + 8 * fq) = o;
            }
    }
};

template <int MODE> struct EpiResid {
    static constexpr bool PERM = true, AFTER_DRAIN = false;
    const float* x; float* h; bf16_t* xb; float* ss; float scale;
    __device__ __forceinline__ void operator()(const f32x4 (&acc)[2][2][4][2], const Unit& u, int wr, int wc, int fr, int fq) const {
#pragma unroll
        for (int ai = 0; ai < 2; ++ai)
#pragma unroll
            for (int m = 0; m < 4; ++m) {
                const int row = u.pm * BM + ai * HALF + wr * 64 + m * 16 + fr;
                bf16_t* rowp = xb + (size_t)row * 1024 + u.pn * BM + wc * 32 + 8 * fq;
                float q = 0.f;
#pragma unroll
                for (int bj = 0; bj < 2; ++bj) {
                    const u32x4 w = *(const u32x4*)(rowp + bj * HALF);
                    const f32x4 b0 = (f32x4){__builtin_bit_cast(float, w.x << 16), __builtin_bit_cast(float, w.x & 0xffff0000u), __builtin_bit_cast(float, w.y << 16), __builtin_bit_cast(float, w.y & 0xffff0000u)};
                    const f32x4 b1 = (f32x4){__builtin_bit_cast(float, w.z << 16), __builtin_bit_cast(float, w.z & 0xffff0000u), __builtin_bit_cast(float, w.w << 16), __builtin_bit_cast(float, w.w & 0xffff0000u)};
                    const f32x4 v0 = b0 + acc[ai][bj][m][0] * scale, v1 = b1 + acc[ai][bj][m][1] * scale;
                    u32x4 o; o.x = cvt_pk_bf16(v0[0], v0[1]); o.y = cvt_pk_bf16(v0[2], v0[3]); o.z = cvt_pk_bf16(v1[0], v1[1]); o.w = cvt_pk_bf16(v1[2], v1[3]);
                    *(u32x4*)(rowp + bj * HALF) = o;
                    q += ((v0[0] * v0[0] + v0[1] * v0[1]) + (v0[2] * v0[2] + v0[3] * v0[3])) + ((v1[0] * v1[0] + v1[1] * v1[1]) + (v1[2] * v1[2] + v1[3] * v1[3]));
                }
                q = sum_xor16_32(q);
                if (fq == 0) atomicAdd(ss + row, q);
            }
    }
};

struct EpiProj {
    static constexpr bool PERM = true, AFTER_DRAIN = false;
    const float* ss; bf16_t* mix; bf16_t* kb; bf16_t* vt; bf16_t* pb;
    __device__ __forceinline__ void operator()(const f32x4 (&acc)[2][2][4][2], const Unit& u, int wr, int wc, int fr, int fq) const {
#pragma unroll
        for (int ai = 0; ai < 2; ++ai)
#pragma unroll
            for (int m = 0; m < 4; ++m) {
                const int row = u.pm * BM + ai * HALF + wr * 64 + m * 16 + fr;
                const float rs = rstd_of(ss[row]);
                const int bb = row >> 12, tt = row & 4095;
#pragma unroll
                for (int bj = 0; bj < 2; ++bj) {
                    const int col = u.pn * BM + bj * HALF + wc * 32 + 8 * fq;
                    const f32x4 v0 = acc[ai][bj][m][0] * rs, v1 = acc[ai][bj][m][1] * rs;
                    u32x4 w; w.x = cvt_pk_bf16(v0[0], v0[1]); w.y = cvt_pk_bf16(v0[2], v0[3]); w.z = cvt_pk_bf16(v1[0], v1[1]); w.w = cvt_pk_bf16(v1[2], v1[3]);
                    if (u.pn < 2) *(u32x4*)(mix + (size_t)row * 1024 + col) = w;
                    else if (u.pn < 4) *(u32x4*)(kb + ((size_t)bb * 4112 + 16 + tt) * 512 + (col - 512)) = w;
                    else if (u.pn < 6) {
                        const int vc = col - 1024, hh = vc >> 6, d0 = vc & 63;
                        bf16_t* p = vt + ((size_t)(bb * 8 + hh) * 64 + d0) * 4128 + 32 + tt;
                        p[0] = (bf16_t)(w.x & 0xffffu); p[4128] = (bf16_t)(w.x >> 16); p[2 * 4128] = (bf16_t)(w.y & 0xffffu); p[3 * 4128] = (bf16_t)(w.y >> 16);
                        p[4 * 4128] = (bf16_t)(w.z & 0xffffu); p[5 * 4128] = (bf16_t)(w.z >> 16); p[6 * 4128] = (bf16_t)(w.w & 0xffffu); p[7 * 4128] = (bf16_t)(w.w >> 16);
                    } else *(u32x4*)(pb + (size_t)row * 1792 + (col - 1536)) = w;
                }
            }
    }
};
template <class Epi, class Sched, bool ALIGN_EPI = false, bool SP2 = false>
__device__ __forceinline__ void gemm_phase(PG8_LAS unsigned char* lds, const Gemm g, const Sched& S, const Epi& E) {
    int tid_ = threadIdx.x; asm volatile("" : "+v"(tid_));
    const int tid = tid_, wid = __builtin_amdgcn_readfirstlane(tid >> 6), lane = tid & 63, wr = wid >> 2, wc = wid & 3, fr = lane & 15, fq = lane >> 4;
    const int K = g.K, nt = K / BK;
    unsigned voffA[2], voffB[2];
#pragma unroll
    for (int i = 0; i < 2; ++i) { int R, C; stage_rc(tid * 16 + i * 8192, R, C); const int Rb = Epi::PERM ? ((R & ~31) + perm32(R & 31)) : R;
        voffA[i] = (unsigned)(R * K + C) * 2u; voffB[i] = (unsigned)(Rb * K + C) * 2u; }
    const size_t kstep = (size_t)(BK * 2);
    const size_t hstep = (size_t)HALF * K * 2;
    const size_t tstep = 2 * hstep;
    const unsigned ldsw = (unsigned)wid * 1024u;
    const int aoff = lds_byte(wr * 64 + fr, fq * 8), boff = lds_byte(wc * 32 + fr, fq * 8);
#define PG8_SA(b, h) (((b) * 2 + (h)) * HTB)
#define PG8_SB(b, h) ((4 + (b) * 2 + (h)) * HTB)
#define PG8_STAGE(bufoff, gbase, voff) do { _Pragma("unroll") for (int _i = 0; _i < 2; ++_i) \
        __builtin_amdgcn_global_load_lds((const unsigned*)((const char*)(gbase) + (voff)[_i]), (PG8_LAS unsigned*)(lds + (bufoff) + ldsw + _i * 8192), 16, 0, 0); } while (0)
#define PG8_LDA(dst, b, h) do { _Pragma("unroll") for (int m = 0; m < 4; ++m) _Pragma("unroll") for (int k = 0; k < 2; ++k) dst[m][k] = *(const PG8_LAS bf16x8*)(lds + PG8_SA(b, h) + aoff + m * 2048 + k * 1024); } while (0)
#define PG8_LDB(dst, b, h) do { _Pragma("unroll") for (int n = 0; n < 2; ++n) _Pragma("unroll") for (int k = 0; k < 2; ++k) dst[n][k] = *(const PG8_LAS bf16x8*)(lds + PG8_SB(b, h) + boff + n * 2048 + k * 1024); } while (0)
#define PG8_MMA(ai, bj, At, Bt) do { __builtin_amdgcn_s_setprio(1); _Pragma("unroll") for (int m = 0; m < 4; ++m) _Pragma("unroll") for (int n = 0; n < 2; ++n) _Pragma("unroll") for (int k = 0; k < 2; ++k) \
        acc[ai][bj][m][n] = __builtin_amdgcn_mfma_f32_16x16x32_bf16(Bt[n][k], At[m][k], acc[ai][bj][m][n], 0, 0, 0); __builtin_amdgcn_s_setprio(0); } while (0)
#define PG8_WAIT_V(n) asm volatile("s_waitcnt vmcnt(" #n ")" ::: "memory")
#define PG8_WAIT_L(n) asm volatile("s_waitcnt lgkmcnt(" #n ")" ::: "memory")
#define PG8_BAR __builtin_amdgcn_s_barrier()
#define PG8_SCHED __builtin_amdgcn_sched_barrier(0)
    Unit cur, nxt; int ui = 0;
    if (!S.next(0, cur)) return;
    f32x4 acc[2][2][4][2];
#pragma unroll
    for (int a = 0; a < 2; ++a)
#pragma unroll
        for (int b = 0; b < 2; ++b)
#pragma unroll
            for (int m = 0; m < 4; ++m)
#pragma unroll
                for (int n = 0; n < 2; ++n) acc[a][b][m][n] = (f32x4){0.f, 0.f, 0.f, 0.f};
    bf16x8 At[4][2], B0[2][2], B1[2][2];
    const char* cA = (const char*)g.A + (size_t)cur.pm * tstep; const char* cB = (const char*)g.Bt + (size_t)cur.pn * tstep;
    S.a_ready(cur);
    if constexpr (SP2) {
        PG8_STAGE(PG8_SB(0, 0), cB, voffB); PG8_STAGE(PG8_SB(0, 1), cB + hstep, voffB); PG8_STAGE(PG8_SA(0, 0), cA, voffA); PG8_STAGE(PG8_SA(0, 1), cA + hstep, voffA);
        if (wr == 1) PG8_BAR;
        PG8_WAIT_V(2); PG8_BAR;
        PG8_STAGE(PG8_SB(1, 0), cB + kstep, voffB); PG8_STAGE(PG8_SA(1, 0), cA + kstep, voffA); PG8_STAGE(PG8_SB(1, 1), cB + hstep + kstep, voffB);
        PG8_WAIT_V(6); PG8_BAR;
    } else {
        PG8_STAGE(PG8_SB(0, 0), cB, voffB); PG8_STAGE(PG8_SA(0, 0), cA, voffA); PG8_STAGE(PG8_SB(0, 1), cB + hstep, voffB); PG8_STAGE(PG8_SA(0, 1), cA + hstep, voffA);
        if (wr == 1) PG8_BAR;
        PG8_WAIT_V(4); PG8_BAR;
        PG8_STAGE(PG8_SB(1, 0), cB + kstep, voffB); PG8_STAGE(PG8_SA(1, 0), cA + kstep, voffA); PG8_STAGE(PG8_SB(1, 1), cB + hstep + kstep, voffB);
        PG8_WAIT_V(6); PG8_BAR;
    }
    for (;;) {
        const bool has_next = S.next(ui + 1, nxt);
        const char* nA = has_next ? (const char*)g.A + (size_t)nxt.pm * tstep : cA; const char* nB = has_next ? (const char*)g.Bt + (size_t)nxt.pn * tstep : cB;
        for (int t = 0; t < nt; t += 2) {
            const bool last = (t == nt - 2);
            const char* a1 = cA + (size_t)(t + 1) * kstep;
            const char* a2 = last ? nA : cA + (size_t)(t + 2) * kstep; const char* b2 = last ? nB : cB + (size_t)(t + 2) * kstep;
            const char* a3 = a2 + kstep; const char* b3 = b2 + kstep;
            if (last && has_next) S.a_ready(nxt);
            if constexpr (SP2) {
            PG8_LDB(B0, 0, 0); PG8_LDB(B1, 0, 1); PG8_SCHED; PG8_LDA(At, 0, 0); PG8_STAGE(PG8_SA(1, 1), a1 + hstep, voffA);
            PG8_WAIT_V(8); PG8_WAIT_L(0); PG8_BAR; PG8_MMA(0, 0, At, B0); PG8_MMA(0, 1, At, B1); PG8_BAR; PG8_SCHED;
            PG8_LDA(At, 0, 1); PG8_STAGE(PG8_SB(0, 0), b2, voffB); PG8_STAGE(PG8_SB(0, 1), b2 + hstep, voffB); PG8_STAGE(PG8_SA(0, 0), a2, voffA);
            PG8_WAIT_V(8); PG8_WAIT_L(0); PG8_BAR; PG8_MMA(1, 0, At, B0); PG8_MMA(1, 1, At, B1); PG8_BAR; PG8_SCHED;
            PG8_LDB(B0, 1, 0); PG8_LDB(B1, 1, 1); PG8_SCHED; PG8_LDA(At, 1, 0); PG8_STAGE(PG8_SA(0, 1), a2 + hstep, voffA);
            PG8_WAIT_V(8); PG8_WAIT_L(0); PG8_BAR; PG8_MMA(0, 0, At, B0); PG8_MMA(0, 1, At, B1); PG8_BAR; PG8_SCHED;
            PG8_LDA(At, 1, 1); PG8_STAGE(PG8_SB(1, 0), b3, voffB); PG8_STAGE(PG8_SB(1, 1), b3 + hstep, voffB); PG8_STAGE(PG8_SA(1, 0), a3, voffA);
            PG8_WAIT_V(8); PG8_WAIT_L(0); PG8_BAR; PG8_MMA(1, 0, At, B0); PG8_MMA(1, 1, At, B1); PG8_BAR; PG8_SCHED;
            } else {
            PG8_LDB(B0, 0, 0); PG8_SCHED; PG8_LDA(At, 0, 0); PG8_STAGE(PG8_SA(1, 1), a1 + hstep, voffA);
            PG8_WAIT_L(8); PG8_BAR; PG8_WAIT_L(0); PG8_MMA(0, 0, At, B0); PG8_BAR; PG8_SCHED;
            PG8_LDB(B1, 0, 1); PG8_STAGE(PG8_SB(0, 0), b2, voffB);
            PG8_BAR; PG8_WAIT_L(0); PG8_MMA(0, 1, At, B1); PG8_BAR;
            PG8_LDA(At, 0, 1); PG8_STAGE(PG8_SA(0, 0), a2, voffA);
            PG8_BAR; PG8_WAIT_L(0); PG8_MMA(1, 0, At, B0); PG8_BAR; PG8_SCHED;
            PG8_STAGE(PG8_SB(0, 1), b2 + hstep, voffB);
            PG8_WAIT_V(6); PG8_BAR; PG8_MMA(1, 1, At, B1); PG8_BAR;
            PG8_LDB(B0, 1, 0); PG8_SCHED; PG8_LDA(At, 1, 0); PG8_STAGE(PG8_SA(0, 1), a2 + hstep, voffA);
            PG8_WAIT_L(8); PG8_BAR; PG8_WAIT_L(0); PG8_MMA(0, 0, At, B0); PG8_BAR; PG8_SCHED;
            PG8_LDB(B1, 1, 1); PG8_STAGE(PG8_SB(1, 0), b3, voffB);
            PG8_BAR; PG8_WAIT_L(0); PG8_MMA(0, 1, At, B1); PG8_BAR;
            PG8_LDA(At, 1, 1); PG8_STAGE(PG8_SA(1, 0), a3, voffA);
            PG8_BAR; PG8_WAIT_L(0); PG8_MMA(1, 0, At, B0); PG8_BAR; PG8_SCHED;
            PG8_STAGE(PG8_SB(1, 1), b3 + hstep, voffB);
            PG8_WAIT_V(6); PG8_BAR; PG8_MMA(1, 1, At, B1); PG8_BAR;
            }
        }
        if constexpr (ALIGN_EPI) { if (wr == 0) PG8_BAR; }
        if constexpr (!Epi::AFTER_DRAIN) { E(acc, cur, wr, wc, fr, fq); S.done(cur); }
        if (!has_next) break;
#pragma unroll
        for (int a = 0; a < 2; ++a)
#pragma unroll
            for (int b = 0; b < 2; ++b)
#pragma unroll
                for (int m = 0; m < 4; ++m)
#pragma unroll
                    for (int n = 0; n < 2; ++n) acc[a][b][m][n] = (f32x4){0.f, 0.f, 0.f, 0.f};
        cur = nxt; cA = nA; cB = nB; ++ui;
        if constexpr (ALIGN_EPI) { if (wr == 1) PG8_BAR; }
    }
    PG8_WAIT_V(0);
    if constexpr (!ALIGN_EPI) { if (wr == 0) PG8_BAR; }
    PG8_BAR;
    if constexpr (Epi::AFTER_DRAIN) { E.fused(acc, cur, wr, wc, fr, fq, lds, wid, lane); S.done(cur); }
#undef PG8_SA
#undef PG8_SB
#undef PG8_STAGE
#undef PG8_LDA
#undef PG8_LDB
#undef PG8_MMA
#undef PG8_WAIT_V
#undef PG8_WAIT_L
#undef PG8_BAR
#undef PG8_SCHED
}
}

#define LAS __attribute__((address_space(3)))
using pg8::bf16_t; using pg8::bf16x8; using pg8::f32x4; using pg8::u32x4; using pg8::u32x2;
typedef float f32x16 __attribute__((ext_vector_type(16)));
constexpr int NWAVES = 8, NTHREADS = 512;
constexpr int MREAL = 32768, MTOK = 32784, MPAD = 33024;
constexpr int DM = 1024, DFF = 2816, NGU = 5632, NIN = 3232, NINP = 3328, PBW = 1792, LK = 4112, VTP = 4128;
constexpr int LDS_BYTES = 135168;

constexpr size_t al4k(size_t x) { return (x + 4095) & ~(size_t)4095; }
constexpr size_t WS_SS = 0;
constexpr size_t WS_LORA = al4k(WS_SS + (size_t)4 * MPAD * 4);
constexpr size_t WS_WGU1 = al4k(WS_LORA + (size_t)512 * 160 * 2);
constexpr size_t WS_WD1 = WS_WGU1 + (size_t)NGU * DM * 2;
constexpr size_t WS_WIN = WS_WD1 + (size_t)DM * DFF * 2;
constexpr size_t WS_WOUT = WS_WIN + (size_t)NINP * DM * 2;
constexpr size_t WS_WGU2 = WS_WOUT + (size_t)DM * DM * 2;
constexpr size_t WS_WD2 = WS_WGU2 + (size_t)NGU * DM * 2;
constexpr size_t WS_XB = al4k(WS_WD2 + (size_t)DM * DFF * 2);
constexpr size_t WS_ACT = al4k(WS_XB + (size_t)MPAD * DM * 2);
constexpr size_t WS_DEC = WS_ACT;
constexpr size_t WS_AA = WS_DEC + (size_t)MTOK * 512 * 4;
constexpr size_t WS_GG = WS_AA + (size_t)MTOK * 512 * 2;
constexpr size_t WS_VT = al4k(WS_GG + (size_t)MTOK * 512 * 2);
constexpr size_t WS_KB = al4k(WS_ACT + (size_t)MPAD * DFF * 2);
constexpr size_t WS_PB = al4k(WS_KB + (size_t)8 * LK * 512 * 2);
constexpr size_t WS_MIX = al4k(WS_PB + (size_t)MPAD * PBW * 2);
constexpr size_t WS_BAR = WS_MIX + (size_t)MPAD * DM * 2;
constexpr size_t WS_END = WS_BAR + 16384;
static_assert(WS_VT + (size_t)64 * 64 * VTP * 2 <= WS_KB, "ACT overlay");
static_assert((size_t)MTOK * 512 * 4 <= (size_t)MPAD * DM * 2 && (size_t)MTOK * 512 * 2 <= (size_t)8 * LK * 512 * 2, "overlays");
static_assert(WS_END <= (size_t)536870912, "workspace");

struct Params { const float* in[25]; float* out; unsigned char* ws; };

__device__ __forceinline__ unsigned f2bf(float f) { unsigned u = __builtin_bit_cast(unsigned, f); return (u + 0x7fffu + ((u >> 16) & 1u)) >> 16; }
typedef float f32x2_t __attribute__((ext_vector_type(2))); typedef __bf16 bf16x2_t __attribute__((ext_vector_type(2)));
__device__ __forceinline__ unsigned pk2(float lo, float hi) { const f32x2_t v = {lo, hi}; const bf16x2_t b = __builtin_convertvector(v, bf16x2_t); return __builtin_bit_cast(unsigned, b); }
__device__ __forceinline__ float bflo(unsigned w) { return __builtin_bit_cast(float, w << 16); }
__device__ __forceinline__ float bfhi(unsigned w) { return __builtin_bit_cast(float, w & 0xffff0000u); }
__device__ __forceinline__ float wave_sum(float v) {
#pragma unroll
    for (int o = 1; o < 64; o <<= 1) v += __shfl_xor(v, o);
    return v;
}
__device__ __forceinline__ float sigmoidf_(float x) { return __builtin_amdgcn_rcpf(1.0f + __expf(-x)); }
__device__ __forceinline__ int prev_row(int row) { if (row >= MREAL) return row == MREAL ? -1 : row - 1; return (row & 4095) == 0 ? (MTOK - 1) : row - 1; }

__device__ __forceinline__ void p0_item(const float* __restrict__ W, int K, int N, bf16_t* WT, LAS float* scr, int item, int lane, const float* __restrict__ gain, int mode, float qscale, int nq) {
    const int nblk = N / 32, kb = item / nblk, nb = item % nblk, k0 = 64 * kb, n0 = 32 * nb;
    const float cs = (n0 < nq) ? qscale : 1.0f;
    const int lr = lane >> 3, lc = 4 * (lane & 7);
#pragma unroll 4
    for (int i = 0; i < 8; ++i) { const int kk = 8 * i + lr; const f32x4 wv = __builtin_nontemporal_load((const f32x4*)(W + (size_t)(k0 + kk) * N + n0 + lc)); const float g = gain ? gain[k0 + kk] * cs : cs;
        LAS float* d = scr + kk * 33 + lc; d[0] = wv[0] * g; d[1] = wv[1] * g; d[2] = wv[2] * g; d[3] = wv[3] * g; }
    asm volatile("s_waitcnt lgkmcnt(0)" ::: "memory");
    const int c = lane & 7;
#pragma unroll
    for (int j = 0; j < 4; ++j) { const int n = (lane >> 3) + 8 * j; const LAS float* s = scr + (8 * c) * 33 + n;
        u32x4 o; o.x = pk2(s[0 * 33], s[1 * 33]); o.y = pk2(s[2 * 33], s[3 * 33]); o.z = pk2(s[4 * 33], s[5 * 33]); o.w = pk2(s[6 * 33], s[7 * 33]);
        const int ng = n0 + n; const int orow = mode == 0 ? ng : (((ng >> 7) << 8) + (ng & 127) + (mode == 2 ? 128 : 0));
        *(u32x4*)(WT + (size_t)orow * K + k0 + 8 * c) = o; }
    asm volatile("s_waitcnt lgkmcnt(0)" ::: "memory");
}

__device__ __forceinline__ void phase_prologue(const Params& p, LAS unsigned char* lds, int G, int bid, int tid) {
    const int lane = tid & 63, wave = tid >> 6;
    LAS float* scr = (LAS float*)(lds + wave * 16384);
    const int gw = bid * NWAVES + wave, NGW = G * NWAVES;
    unsigned char* ws = p.ws;
    constexpr int I_GU = (DM / 64) * (DFF / 32), I_D = (DFF / 64) * (DM / 32), I_IN = (DM / 64) * (NIN / 32), I_O = (DM / 64) * (DM / 32);
    constexpr int NITEMS = 4 * I_GU + 2 * I_D + I_IN + I_O;
    for (int it = gw; it < NITEMS; it += NGW) {
        int r = it;
        if (r < I_GU) { p0_item(p.in[3], DM, DFF, (bf16_t*)(ws + WS_WGU1), scr, r, lane, p.in[2], 1, 1.f, 0); continue; } r -= I_GU;
        if (r < I_GU) { p0_item(p.in[4], DM, DFF, (bf16_t*)(ws + WS_WGU1), scr, r, lane, p.in[2], 2, 1.f, 0); continue; } r -= I_GU;
        if (r < I_GU) { p0_item(p.in[21], DM, DFF, (bf16_t*)(ws + WS_WGU2), scr, r, lane, p.in[20], 1, 1.f, 0); continue; } r -= I_GU;
        if (r < I_GU) { p0_item(p.in[22], DM, DFF, (bf16_t*)(ws + WS_WGU2), scr, r, lane, p.in[20], 2, 1.f, 0); continue; } r -= I_GU;
        if (r < I_D) { p0_item(p.in[5], DFF, DM, (bf16_t*)(ws + WS_WD1), scr, r, lane, nullptr, 0, 1.f, 0); continue; } r -= I_D;
        if (r < I_D) { p0_item(p.in[23], DFF, DM, (bf16_t*)(ws + WS_WD2), scr, r, lane, nullptr, 0, 1.f, 0); continue; } r -= I_D;
        if (r < I_IN) { p0_item(p.in[7], DM, NIN, (bf16_t*)(ws + WS_WIN), scr, r, lane, p.in[6], 0, -0.125f * 1.4426950408889634f, 512); continue; } r -= I_IN;
        p0_item(p.in[19], DM, DM, (bf16_t*)(ws + WS_WOUT), scr, r, lane, nullptr, 0, 1.f, 0);
    }
    float* ss = (float*)(ws + WS_SS); bf16_t* xb = (bf16_t*)(ws + WS_XB);
    for (int row0 = gw * 4; row0 < MPAD; row0 += NGW * 4) {
        f32x4 v[4][4];
#pragma unroll
        for (int r = 0; r < 4; ++r) { const int row = row0 + r;
            const float* src = row < MREAL ? p.in[0] + (size_t)row * DM : (row < MTOK ? p.in[1] + (size_t)(row - MREAL) * DM : nullptr);
#pragma unroll
            for (int j = 0; j < 4; ++j) v[r][j] = src ? __builtin_nontemporal_load((const f32x4*)src + lane + 64 * j) : (f32x4){0.f, 0.f, 0.f, 0.f}; }
#pragma unroll
        for (int r = 0; r < 4; ++r) { const int row = row0 + r; float s = 0.f;
#pragma unroll
            for (int j = 0; j < 4; ++j) s += (v[r][j][0] * v[r][j][0] + v[r][j][1] * v[r][j][1]) + (v[r][j][2] * v[r][j][2] + v[r][j][3] * v[r][j][3]);
            s = wave_sum(s);
            u32x2* o = (u32x2*)(xb + (size_t)row * DM);
#pragma unroll
            for (int j = 0; j < 4; ++j) { u32x2 w; w.x = pk2(v[r][j][0], v[r][j][1]); w.y = pk2(v[r][j][2], v[r][j][3]); o[lane + 64 * j] = w; }
            if (lane == 0) { ss[row] = s; ss[MPAD + row] = 0.f; ss[2 * MPAD + row] = 0.f; ss[3 * MPAD + row] = 0.f; } }
    }
    const int gt = bid * NTHREADS + tid, NT = G * NTHREADS;
    bf16_t* wupT = (bf16_t*)(ws + WS_LORA); bf16_t* aupT = wupT + 512 * 32; bf16_t* gupT = aupT + 512 * 32;
    for (int i = gt; i < 512 * 32; i += NT) { const int n = i >> 5, k = i & 31; wupT[i] = (bf16_t)f2bf(p.in[10][k * 512 + n]); aupT[i] = (bf16_t)f2bf(p.in[12][k * 512 + n]); }
    for (int i = gt; i < 512 * 96; i += NT) { const int n = i / 96, k = i % 96; gupT[i] = (bf16_t)f2bf(p.in[13][k * 512 + n]); }
    bf16_t* vt = (bf16_t*)(ws + WS_VT);
    for (int i = gt; i < 4096 * 16; i += NT) vt[(size_t)(i >> 4) * VTP + (i & 15)] = 0;
    unsigned* winpad = (unsigned*)(ws + WS_WIN + (size_t)NIN * DM * 2);
    for (int i = gt; i < (NINP - NIN) * DM / 2; i += NT) winpad[i] = 0u;
}

#define MFMA32(a, b, c) __builtin_amdgcn_mfma_f32_32x32x16_bf16((a), (b), (c), 0, 0, 0)
#define MFMA16(a, b, c) __builtin_amdgcn_mfma_f32_16x16x32_bf16((a), (b), (c), 0, 0, 0)
struct SbState { int active, b, h, m, n; bf16x8 qf[4]; f32x16 o0, o1; float c; bf16x8 nk[4]; };
__device__ __forceinline__ void sb_loadk(bf16x8 (&k)[4], const bf16_t* __restrict__ kbase, int ks, int j) {
    int kp = ks + j; kp = kp < 0 ? 0 : kp;
    const bf16_t* kr = kbase + (size_t)kp * 512;
#pragma unroll
    for (int s = 0; s < 4; ++s) k[s] = *(const bf16x8*)(kr + 16 * s);
}
__device__ __forceinline__ bf16_t* sb_qp(bf16_t* mix, int b, int h, int m, int j) { return mix + ((size_t)b * 4096 + 32 * m + j) * 1024 + h * 64; }
__device__ __forceinline__ const bf16_t* sb_kbase(const bf16_t* kb, int b, int h, int hi) { return kb + (size_t)b * LK * 512 + h * 64 + 8 * hi; }
__device__ __forceinline__ const bf16_t* sb_vbase(const bf16_t* vt, int b, int h, int j, int hi) { return vt + ((size_t)(b * 8 + h) * 64 + j) * VTP + 16 + 4 * hi; }
__device__ __forceinline__ void sb_begin(SbState& st, int b, int h, int m, bf16_t* mix, const bf16_t* __restrict__ kb, const bf16_t* __restrict__ vt, int lane) {
    const int j = lane & 31, hi = lane >> 5;
    const bf16_t* qp = sb_qp(mix, b, h, m, j);
#pragma unroll
    for (int s = 0; s < 4; ++s) st.qf[s] = *(const bf16x8*)(qp + 16 * s + 8 * hi);
#pragma unroll
    for (int i = 0; i < 16; ++i) { st.o0[i] = 0.f; st.o1[i] = 0.f; }
    st.c = 1.0f;
    st.b = b; st.h = h; st.m = m; st.n = 0; st.active = 1;
    sb_loadk(st.nk, sb_kbase(kb, b, h, hi), 16 + 32 * m, j);
}
__device__ __forceinline__ void sb_step(SbState& st, bf16_t* mix, const bf16_t* __restrict__ kb, const bf16_t* __restrict__ vt, int lane) {
    const int j = lane & 31, hi = lane >> 5, m = st.m, n = st.n;
    const int Q0 = 16 + 32 * m;
    {
        const int ks = Q0 - 32 * n;
        const bf16_t* vp = sb_vbase(vt, st.b, st.h, j, hi) + ks;
        u32x2 va[2][2], vb[2][2];
#pragma unroll
        for (int dh = 0; dh < 2; ++dh)
#pragma unroll
            for (int s2 = 0; s2 < 2; ++s2) { va[dh][s2] = *(const u32x2*)(vp + (size_t)dh * 32 * VTP + 16 * s2); vb[dh][s2] = *(const u32x2*)(vp + (size_t)dh * 32 * VTP + 16 * s2 + 8); }
        f32x16 sv;
#pragma unroll
        for (int i = 0; i < 16; ++i) sv[i] = 0.f;
        sv = MFMA32(st.nk[0], st.qf[0], sv); sv = MFMA32(st.nk[1], st.qf[1], sv); sv = MFMA32(st.nk[2], st.qf[2], sv); sv = MFMA32(st.nk[3], st.qf[3], sv);
        float bt[16], kp_[16];
#pragma unroll
        for (int i = 0; i < 16; ++i) {
            const int ko = 8 * (i >> 2) + 4 * hi + (i & 3);
            const float e = __builtin_amdgcn_exp2f(fminf(sv[i], 80.0f));
            const float be = __builtin_amdgcn_rcpf(1.0f + e);
            const bool valid = (ks + ko >= 0) && (n > 0 || ko < j);
            bt[i] = valid ? be : 0.0f; kp_[i] = valid ? e * be : 1.0f;
        }
        float pg[4], og[4];
#pragma unroll
        for (int g = 0; g < 4; ++g) { pg[g] = (kp_[4 * g] * kp_[4 * g + 1]) * (kp_[4 * g + 2] * kp_[4 * g + 3]); og[g] = __shfl_xor(pg[g], 32); }
        float at[16]; float cc = st.c;
#pragma unroll
        for (int g = 3; g >= 0; --g) {
            float base = hi ? cc : cc * og[g];
#pragma unroll
            for (int r = 3; r >= 0; --r) { at[4 * g + r] = bt[4 * g + r] * base; base *= kp_[4 * g + r]; }
            cc *= pg[g] * og[g];
        }
        st.c = cc;
        bf16x8 pf[2];
#pragma unroll
        for (int s2 = 0; s2 < 2; ++s2) { u32x4 w; w.x = pk2(at[8 * s2], at[8 * s2 + 1]); w.y = pk2(at[8 * s2 + 2], at[8 * s2 + 3]); w.z = pk2(at[8 * s2 + 4], at[8 * s2 + 5]); w.w = pk2(at[8 * s2 + 6], at[8 * s2 + 7]); pf[s2] = __builtin_bit_cast(bf16x8, w); }
#pragma unroll
        for (int s2 = 0; s2 < 2; ++s2) {
            u32x4 a0; a0.x = va[0][s2].x; a0.y = va[0][s2].y; a0.z = vb[0][s2].x; a0.w = vb[0][s2].y;
            u32x4 a1; a1.x = va[1][s2].x; a1.y = va[1][s2].y; a1.z = vb[1][s2].x; a1.w = vb[1][s2].y;
            st.o0 = MFMA32(__builtin_bit_cast(bf16x8, a0), pf[s2], st.o0);
            st.o1 = MFMA32(__builtin_bit_cast(bf16x8, a1), pf[s2], st.o1);
        }
    }
    st.n = n + 1;
    if (n + 1 > m + 1 || __all(st.c < 1e-24f)) {
        bf16_t* qp = sb_qp(mix, st.b, st.h, m, j);
#pragma unroll
        for (int g = 0; g < 4; ++g) {
            u32x2 w; w.x = pk2(st.o0[4 * g], st.o0[4 * g + 1]); w.y = pk2(st.o0[4 * g + 2], st.o0[4 * g + 3]); *(u32x2*)(qp + 8 * g + 4 * hi) = w;
            u32x2 w1; w1.x = pk2(st.o1[4 * g], st.o1[4 * g + 1]); w1.y = pk2(st.o1[4 * g + 2], st.o1[4 * g + 3]); *(u32x2*)(qp + 32 + 8 * g + 4 * hi) = w1;
        }
        st.active = 0;
    } else sb_loadk(st.nk, sb_kbase(kb, st.b, st.h, hi), Q0 - 32 * (n + 1), j);
}
__device__ __forceinline__ void sb_advance(SbState& st, int& next, int stride, bf16_t* mix, const bf16_t* kb, const bf16_t* vt, int lane) {
    if (!st.active) { if (next < 8192) { const int uu = 8191 - next; next += stride; sb_begin(st, uu >> 10, (uu >> 7) & 7, uu & 127, mix, kb, vt, lane); } }
    else sb_step(st, mix, kb, vt, lane);
}

template <int FN> __device__ __forceinline__ bf16x8 rp_frag(const bf16_t* __restrict__ pb, int row, int prow, int col, const float* __restrict__ mu) {
    const u32x4 cur = *(const u32x4*)(pb + (size_t)row * PBW + col);
    u32x4 prv = (u32x4){0u, 0u, 0u, 0u};
    if (prow >= 0) prv = *(const u32x4*)(pb + (size_t)prow * PBW + col);
    const f32x4 m0 = *(const f32x4*)(mu + col), m1 = *(const f32x4*)(mu + col + 4);
    float x[8];
#pragma unroll
    for (int i = 0; i < 4; ++i) {
        const float c0 = bflo(cur[i]), c1 = bfhi(cur[i]), p0 = bflo(prv[i]), p1 = bfhi(prv[i]);
        const float mu0 = (i < 2) ? m0[2 * i] : m1[2 * i - 4], mu1 = (i < 2) ? m0[2 * i + 1] : m1[2 * i - 3];
        x[2 * i] = c0 + (p0 - c0) * mu0; x[2 * i + 1] = c1 + (p1 - c1) * mu1;
    }
#pragma unroll
    for (int i = 0; i < 8; ++i) {
        if (FN == 1) x[i] = 1.0f - 2.0f * __builtin_amdgcn_rcpf(__expf(2.0f * x[i]) + 1.0f);
        if (FN == 2) x[i] = sigmoidf_(x[i]);
    }
    u32x4 o; o.x = pk2(x[0], x[1]); o.y = pk2(x[2], x[3]); o.z = pk2(x[4], x[5]); o.w = pk2(x[6], x[7]);
    return __builtin_bit_cast(bf16x8, o);
}
struct RpW { bf16x8 Aw, Aa, Ag0, Ag1, Ag2; f32x4 w0v, a0v; };
__device__ __forceinline__ void rp_wload(RpW& w, const bf16_t* __restrict__ wupT, const bf16_t* __restrict__ aupT, const bf16_t* __restrict__ gupT, const float* __restrict__ w0, const float* __restrict__ a0, int cb, int n, int kq) {
    const int col = 16 * cb + n, oc = 16 * cb + 4 * kq;
    w.Aw = *(const bf16x8*)(wupT + col * 32 + 8 * kq); w.Aa = *(const bf16x8*)(aupT + col * 32 + 8 * kq);
    w.Ag0 = *(const bf16x8*)(gupT + col * 96 + 8 * kq); w.Ag1 = *(const bf16x8*)(gupT + col * 96 + 32 + 8 * kq); w.Ag2 = *(const bf16x8*)(gupT + col * 96 + 64 + 8 * kq);
    w.w0v = *(const f32x4*)(w0 + oc); w.a0v = *(const f32x4*)(a0 + oc);
}
__device__ __forceinline__ void rp_item(const Params& p, int tg, int cb0, int ncb, int lane) {
    unsigned char* ws = p.ws;
    const bf16_t* pb = (const bf16_t*)(ws + WS_PB);
    const bf16_t* wupT = (const bf16_t*)(ws + WS_LORA); const bf16_t* aupT = wupT + 512 * 32; const bf16_t* gupT = aupT + 512 * 32;
    float* dec = (float*)(ws + WS_DEC); bf16_t* aa = (bf16_t*)(ws + WS_AA); bf16_t* gg = (bf16_t*)(ws + WS_GG);
    const int n = lane & 15, kq = lane >> 4, row = tg * 16 + n, prow = prev_row(row);
    const float* mu = p.in[8];
    const bf16x8 Bw = rp_frag<1>(pb, row, prow, 1536 + 8 * kq, mu), Ba = rp_frag<0>(pb, row, prow, 1568 + 8 * kq, mu);
    const bf16x8 Bg0 = rp_frag<2>(pb, row, prow, 1600 + 8 * kq, mu), Bg1 = rp_frag<2>(pb, row, prow, 1632 + 8 * kq, mu), Bg2 = rp_frag<2>(pb, row, prow, 1664 + 8 * kq, mu);
    const float* w0 = p.in[9]; const float* a0 = p.in[11];
    RpW nw; rp_wload(nw, wupT, aupT, gupT, w0, a0, cb0, n, kq);
    for (int cb = cb0; cb < cb0 + ncb; ++cb) {
        const RpW cw = nw;
        if (cb + 1 < cb0 + ncb) rp_wload(nw, wupT, aupT, gupT, w0, a0, cb + 1, n, kq);
        const bf16x8 Aw = cw.Aw, Aa = cw.Aa, Ag0 = cw.Ag0, Ag1 = cw.Ag1, Ag2 = cw.Ag2;
        const f32x4 z = (f32x4){0.f, 0.f, 0.f, 0.f};
        const f32x4 Dw = MFMA16(Aw, Bw, z), Da = MFMA16(Aa, Ba, z);
        f32x4 Dg = MFMA16(Ag0, Bg0, z); Dg = MFMA16(Ag1, Bg1, Dg); Dg = MFMA16(Ag2, Bg2, Dg);
        const int oc = 16 * cb + 4 * kq;
        const f32x4 w0v = cw.w0v, a0v = cw.a0v;
        f32x4 dv; float av[4];
#pragma unroll
        for (int r = 0; r < 4; ++r) { dv[r] = __expf(-0.6065306597126334f * sigmoidf_(Dw[r] + w0v[r])); av[r] = sigmoidf_(Da[r] + a0v[r]); }
        *(f32x4*)(dec + (size_t)row * 512 + oc) = dv;
        u32x2 wa; wa.x = pk2(av[0], av[1]); wa.y = pk2(av[2], av[3]); *(u32x2*)(aa + (size_t)row * 512 + oc) = wa;
        u32x2 wg; wg.x = pk2(Dg[0], Dg[1]); wg.y = pk2(Dg[2], Dg[3]); *(u32x2*)(gg + (size_t)row * 512 + oc) = wg;
    }
}


template <int MODE> __device__ __forceinline__ void meta_gemm(const Params& p, LAS unsigned char* lds, int G, int bid, int tid) {
    unsigned char* ws = p.ws;
    const int lane = tid & 63, wave = tid >> 6, n = lane & 15, kq = lane >> 4;
    constexpr int K = (MODE == 2) ? DFF : DM, KW = K / 8, NIT = (MODE == 1) ? NGU / 32 : (MODE == 2 ? DM / 16 : NINP / 16);
    const bf16_t* A = (MODE == 2) ? (const bf16_t*)(ws + WS_ACT) : (const bf16_t*)(ws + WS_XB);
    const bf16_t* W = (const bf16_t*)(ws + (MODE == 1 ? WS_WGU1 : (MODE == 2 ? WS_WD1 : WS_WIN)));
    float* ss = (float*)(ws + WS_SS);
    LAS f32x4* part = (LAS f32x4*)lds;
    constexpr int NUN3 = (MREAL / 256) * (NINP / 256);
    const int rem3 = (MODE == 3) ? NUN3 % G : 0;
    const int first = (rem3 > 0) ? bid - rem3 : bid, stride = (rem3 > 0) ? G - rem3 : G;
    for (int it = first; it < NIT; it += stride) {
        if (it < 0) break;
        const bf16_t* ap = A + (size_t)(MREAL + n) * K + wave * KW + 8 * kq;
        const int wrow = (MODE == 1) ? ((((16 * it) >> 7) << 8) + ((16 * it) & 127)) : 16 * it;
        const bf16_t* wp = W + (size_t)(wrow + n) * K + wave * KW + 8 * kq;
        f32x4 acc0 = (f32x4){0.f, 0.f, 0.f, 0.f}, acc1 = acc0;
#pragma unroll
        for (int ks = 0; ks < KW / 32; ++ks) {
            const bf16x8 a = *(const bf16x8*)(ap + 32 * ks);
            acc0 = MFMA16(*(const bf16x8*)(wp + 32 * ks), a, acc0);
            if (MODE == 1) acc1 = MFMA16(*(const bf16x8*)(wp + (size_t)128 * K + 32 * ks), a, acc1);
        }
        part[wave * 64 + lane] = acc0;
        if (MODE == 1) part[512 + wave * 64 + lane] = acc1;
        __syncthreads();
        if (wave == 0) {
            f32x4 s0 = part[lane], s1 = (f32x4){0.f, 0.f, 0.f, 0.f};
#pragma unroll
            for (int w = 1; w < 8; ++w) s0 += part[w * 64 + lane];
            if (MODE == 1) { s1 = part[512 + lane];
#pragma unroll
                for (int w = 1; w < 8; ++w) s1 += part[512 + w * 64 + lane]; }
            const int row = MREAL + n;
            if (MODE == 1) {
                const float rs = pg8::rstd_of(ss[row]);
                float a[4];
#pragma unroll
                for (int r = 0; r < 4; ++r) { const float g = s0[r] * rs; a[r] = g * __builtin_amdgcn_rcpf(1.0f + __expf(-g)) * (s1[r] * rs); }
                u32x2 w; w.x = pk2(a[0], a[1]); w.y = pk2(a[2], a[3]);
                *(u32x2*)((bf16_t*)(ws + WS_ACT) + (size_t)row * DFF + 16 * it + 4 * kq) = w;
            } else if (MODE == 2) {
                const int col = 16 * it + 4 * kq;
                const f32x4 b = *(const f32x4*)(p.in[1] + (size_t)n * DM + col);
                const f32x4 v = b + s0 * 0.5f;
                u32x2 w; w.x = pk2(v[0], v[1]); w.y = pk2(v[2], v[3]);
                *(u32x2*)((bf16_t*)(ws + WS_XB) + (size_t)row * DM + col) = w;
                float q = (v[0] * v[0] + v[1] * v[1]) + (v[2] * v[2] + v[3] * v[3]);
                q += __shfl_xor(q, 16); q += __shfl_xor(q, 32);
                if (kq == 0) atomicAdd(ss + MPAD + row, q);
            } else {
                const int col = 16 * it + 4 * kq;
                const float rs = pg8::rstd_of(ss[MPAD + row]);
                const f32x4 v = s0 * rs;
                u32x2 w; w.x = pk2(v[0], v[1]); w.y = pk2(v[2], v[3]);
                if (col >= 1536) *(u32x2*)((bf16_t*)(ws + WS_PB) + (size_t)row * PBW + (col - 1536)) = w;
                else if (col >= 1024) {
                    const int vc = col - 1024, hh = vc >> 6, d0 = vc & 63;
                    const bf16_t e0 = (bf16_t)(w.x & 0xffffu), e1 = (bf16_t)(w.x >> 16), e2 = (bf16_t)(w.y & 0xffffu), e3 = (bf16_t)(w.y >> 16);
                    for (int b2 = 0; b2 < 8; ++b2) { bf16_t* o = (bf16_t*)(ws + WS_VT) + ((size_t)(b2 * 8 + hh) * 64 + d0) * VTP + 16 + n; o[0] = e0; o[VTP] = e1; o[2 * VTP] = e2; o[3 * VTP] = e3; }
                } else if (col >= 512) {
                    for (int b2 = 0; b2 < 8; ++b2) *(u32x2*)((bf16_t*)(ws + WS_KB) + ((size_t)b2 * LK + n) * 512 + (col - 512)) = w;
                }
            }
        }
        __syncthreads();
    }
}

template <int CTRL> __device__ __forceinline__ float dpp_mov(float x) { return __builtin_bit_cast(float, __builtin_amdgcn_update_dpp(0, __builtin_bit_cast(int, x), CTRL, 0xf, 0xf, false)); }
template <int CTRL> __device__ __forceinline__ float dpp_add(float x) { return x + dpp_mov<CTRL>(x); }
__device__ __forceinline__ float row16_sum(float x) { x = dpp_add<0x128>(x); x = dpp_add<0x124>(x); x = dpp_add<0x122>(x); x = dpp_add<0x121>(x); return x; }
constexpr int SC_T = 32, SC_NCH = (LK + SC_T - 1) / SC_T, SC_TOKF = 6 * 64 + 4, SC_BUF = SC_T * SC_TOKF * 4;
constexpr int SC_VT = 2 * SC_BUF + 2 * SC_T * 16 * 4, SC_VTB = 16 * SC_T * 4;
constexpr int SC_OUT = 2 * SC_BUF, SC_OUTB = SC_T * 16 * 4;
#define SC_BARRIER() do { asm volatile("s_waitcnt lgkmcnt(0)" ::: "memory"); __builtin_amdgcn_s_barrier(); asm volatile("" ::: "memory"); } while (0)
__device__ __forceinline__ int seq_row(int b, int s) { return s < 16 ? MREAL + s : b * 4096 + s - 16; }
struct ScRaw { u32x2 r, k, v, rp, kp, vp, a; f32x4 d; };
__device__ __forceinline__ void sc_load(ScRaw& w, const bf16_t* __restrict__ pb, const float* __restrict__ dec, const bf16_t* __restrict__ aa, int b, int s, int col) {
    s = s < LK ? s : LK - 1;
    const int row = seq_row(b, s), prow = prev_row(row);
    const bf16_t* pr = pb + (size_t)row * PBW + col;
    w.r = *(const u32x2*)(pr); w.k = *(const u32x2*)(pr + 512); w.v = *(const u32x2*)(pr + 1024);
    w.rp = (u32x2){0u, 0u}; w.kp = (u32x2){0u, 0u}; w.vp = (u32x2){0u, 0u};
    if (prow >= 0) { const bf16_t* pp = pb + (size_t)prow * PBW + col; w.rp = *(const u32x2*)(pp); w.kp = *(const u32x2*)(pp + 512); w.vp = *(const u32x2*)(pp + 1024); }
    w.d = *(const f32x4*)(dec + (size_t)row * 512 + col);
    w.a = *(const u32x2*)(aa + (size_t)row * 512 + col);
}
__device__ __forceinline__ f32x4 unpk4(u32x2 w) { return (f32x4){bflo(w.x), bfhi(w.x), bflo(w.y), bfhi(w.y)}; }
__device__ __forceinline__ f32x4 sc_produce(const ScRaw& w, LAS float* tokp, int cg, f32x4 mur, f32x4 muk, f32x4 muv, f32x4 kkw, f32x4 kaw, f32x4 rkw, LAS float* vtp, bool mine) {
    const f32x4 r0 = unpk4(w.r), k0 = unpk4(w.k), v0 = unpk4(w.v);
    const f32x4 r = r0 + (unpk4(w.rp) - r0) * mur, k = k0 + (unpk4(w.kp) - k0) * muk, v = v0 + (unpk4(w.vp) - v0) * muv;
    const f32x4 a = unpk4(w.a);
    f32x4 kk = k * kkw;
    float ssq = (kk[0] * kk[0] + kk[1] * kk[1]) + (kk[2] * kk[2] + kk[3] * kk[3]);
    ssq = row16_sum(ssq);
    const float inv = __builtin_amdgcn_rsqf(fmaxf(ssq, 1e-24f));
    kk = kk * inv;
    const f32x4 k2 = k * (1.0f + (a - 1.0f) * kaw);
    const f32x4 t = r * k2 * rkw;
    float bs = (t[0] + t[1]) + (t[2] + t[3]);
    bs = row16_sum(bs);
    *(LAS f32x4*)(tokp + 0 * 64 + 4 * cg) = r;
    *(LAS f32x4*)(tokp + 1 * 64 + 4 * cg) = w.d;
    *(LAS f32x4*)(tokp + 2 * 64 + 4 * cg) = k2;
    *(LAS f32x4*)(tokp + 3 * 64 + 4 * cg) = -kk;
    *(LAS f32x4*)(tokp + 4 * 64 + 4 * cg) = kk * a;
    if (mine) { vtp[0] = v[0]; vtp[SC_T] = v[1]; vtp[2 * SC_T] = v[2]; vtp[3 * SC_T] = v[3]; }
    return v * bs;
}
typedef float f32x2v __attribute__((ext_vector_type(2)));
struct ScStep { f32x4 r, w, k2, nkk, kka; };
__device__ __forceinline__ void sc_fetch(ScStep& x, const LAS float* tp, int c4, int irow) {
    x.r = *(const LAS f32x4*)(tp + c4); x.w = *(const LAS f32x4*)(tp + 64 + c4); x.k2 = *(const LAS f32x4*)(tp + 128 + c4);
    x.nkk = *(const LAS f32x4*)(tp + 192 + c4); x.kka = *(const LAS f32x4*)(tp + 256 + c4);
}
__device__ __forceinline__ void phase_scan(const Params& p, LAS unsigned char* lds, int G, int bid, int tid) {
    unsigned char* ws = p.ws;
    const bf16_t* pb = (const bf16_t*)(ws + WS_PB); const float* dec = (const float*)(ws + WS_DEC); const bf16_t* aa = (const bf16_t*)(ws + WS_AA);
    float* Y = p.out; bf16_t* BV = (bf16_t*)(p.out + 16777216);
    const int lane = tid & 63, wave = tid >> 6;
    if (wave >= 4) {
        bf16_t* mix = (bf16_t*)(ws + WS_MIX); const bf16_t* kbuf = (const bf16_t*)(ws + WS_KB); const bf16_t* vtbuf = (const bf16_t*)(ws + WS_VT);
        SbState sb; sb.active = 0; int sb_next = bid * 4 + (wave - 4); const int sb_stride = G * 4;
        for (int unit = bid; unit < 256; unit += G) {
            const int hd = (unit & 7) * 8 + (unit >> 5), rq = (unit >> 3) & 3, b = hd >> 3, h = hd & 7;
            const int pt = tid - 256, tl = pt >> 4, cg = pt & 15, col = h * 64 + 4 * cg;
            const bool mine = (cg >> 2) == rq;
            const size_t obase = (size_t)(hd * 4 + rq) * 4096;
            ScRaw n0, n1;
            sc_load(n0, pb, dec, aa, b, tl, col); sc_load(n1, pb, dec, aa, b, tl + 16, col);
            for (int ch = 0; ch <= SC_NCH + 1; ++ch) {
                if (ch >= 2 && pt < 128) {
                    const int cc = ch - 2, t = pt >> 2, s = cc * SC_T + t;
                    if (s >= 16 && s < LK) {
                        const f32x4 yv = *(const LAS f32x4*)(lds + SC_OUT + (cc & 1) * SC_OUTB + (t * 16 + 4 * (pt & 3)) * 4);
                        *(f32x4*)(Y + (obase + (s - 16)) * 16 + 4 * (pt & 3)) = yv;
                    }
                }
                if (ch < SC_NCH) {
                    const f32x4 mur = *(const f32x4*)(p.in[8] + col), muk = *(const f32x4*)(p.in[8] + 512 + col), muv = *(const f32x4*)(p.in[8] + 1024 + col);
                    const f32x4 kkw = *(const f32x4*)(p.in[14] + col), kaw = *(const f32x4*)(p.in[15] + col), rkw = *(const f32x4*)(p.in[16] + col);
                    LAS float* buf = (LAS float*)(lds + (ch & 1) * SC_BUF); LAS float* vtb = (LAS float*)(lds + SC_VT + (ch & 1) * SC_VTB);
                    const int s0 = ch * SC_T + tl, s1 = s0 + 16;
                    {
                        const ScRaw c0 = n0;
                        if (ch + 1 < SC_NCH) sc_load(n0, pb, dec, aa, b, (ch + 1) * SC_T + tl, col);
                        const f32x4 bv0 = sc_produce(c0, buf + tl * SC_TOKF, cg, mur, muk, muv, kkw, kaw, rkw, vtb + (4 * (cg & 3)) * SC_T + tl, mine);
                        if (mine && s0 >= 16 && s0 < LK) { u32x2 w; w.x = pk2(bv0[0], bv0[1]); w.y = pk2(bv0[2], bv0[3]); *(u32x2*)(BV + (obase + (s0 - 16)) * 16 + 4 * (cg & 3)) = w; }
                    }
                    {
                        const ScRaw c1 = n1;
                        if (ch + 1 < SC_NCH) sc_load(n1, pb, dec, aa, b, (ch + 1) * SC_T + tl + 16, col);
                        const f32x4 bv1 = sc_produce(c1, buf + (tl + 16) * SC_TOKF, cg, mur, muk, muv, kkw, kaw, rkw, vtb + (4 * (cg & 3)) * SC_T + tl + 16, mine);
                        if (mine && s1 >= 16 && s1 < LK) { u32x2 w; w.x = pk2(bv1[0], bv1[1]); w.y = pk2(bv1[2], bv1[3]); *(u32x2*)(BV + (obase + (s1 - 16)) * 16 + 4 * (cg & 3)) = w; }
                    }
                }
                sb_advance(sb, sb_next, sb_stride, mix, kbuf, vtbuf, lane);
                SC_BARRIER();
            }
        }
        while (sb.active || sb_next < 8192) sb_advance(sb, sb_next, sb_stride, mix, kbuf, vtbuf, lane);
    } else {
        for (int unit = bid; unit < 256; unit += G) {
            const int rq = (unit >> 3) & 3;
            const int rg = lane >> 4, c = lane & 15, c4 = 4 * c, irow = rq * 16 + wave * 4 + rg;
            const bool odd = c & 1, hi2 = (c >> 1) & 1;
            f32x4 S = (f32x4){0.f, 0.f, 0.f, 0.f};
            for (int ch = 0; ch <= SC_NCH + 1; ++ch) {
                if (ch >= 1 && ch <= SC_NCH) {
                    const int cc = ch - 1;
                    const LAS float* buf = (const LAS float*)(lds + (cc & 1) * SC_BUF);
                    LAS float* outp = (LAS float*)(lds + SC_OUT + (cc & 1) * SC_OUTB) + wave * 4 + rg;
                    const int s0 = cc * SC_T, ns = (LK - s0) < SC_T ? (LK - s0) : SC_T;
                    const LAS float* vrow = (const LAS float*)(lds + SC_VT + (cc & 1) * SC_VTB) + (wave * 4 + rg) * SC_T;
                    ScStep nx; sc_fetch(nx, buf, c4, irow); f32x4 nv4 = *(const LAS f32x4*)(vrow);
                    for (int t4 = 0; t4 < ns; t4 += 4) {
                        const f32x4 v4 = nv4; nv4 = *(const LAS f32x4*)(vrow + ((t4 + 4) < SC_T ? (t4 + 4) : 0));
                        float yp[4];
#pragma unroll
                        for (int u = 0; u < 4; ++u) {
                            const ScStep x = nx;
                            const int tn = (t4 + u + 1) < SC_T ? (t4 + u + 1) : (SC_T - 1);
                            sc_fetch(nx, buf + tn * SC_TOKF, c4, irow);
                            f32x2v q = __builtin_shufflevector(S, S, 0, 1) * __builtin_shufflevector(x.nkk, x.nkk, 0, 1);
                            q = __builtin_shufflevector(S, S, 2, 3) * __builtin_shufflevector(x.nkk, x.nkk, 2, 3) + q;
                            const float sa = row16_sum(q[0] + q[1]);
                            S = (S * x.w + x.k2 * v4[u]) + x.kka * sa;
                            f32x2v qy = __builtin_shufflevector(S, S, 0, 1) * __builtin_shufflevector(x.r, x.r, 0, 1);
                            qy = __builtin_shufflevector(S, S, 2, 3) * __builtin_shufflevector(x.r, x.r, 2, 3) + qy;
                            yp[u] = qy[0] + qy[1];
                        }
                        const float z01 = (odd ? yp[1] : yp[0]) + dpp_mov<0xB1>(odd ? yp[0] : yp[1]);
                        const float z23 = (odd ? yp[3] : yp[2]) + dpp_mov<0xB1>(odd ? yp[2] : yp[3]);
                        float z = (hi2 ? z23 : z01) + dpp_mov<0x4E>(hi2 ? z01 : z23);
                        z = dpp_add<0x128>(z); z = dpp_add<0x124>(z);
                        outp[(t4 + (c & 3)) * 16] = z;
                    }
                }
                SC_BARRIER();
            }
        }
    }
}

struct PostIn { f32x4 y0, y1; u32x4 bvw, ggw; };
__device__ __forceinline__ void post_load(PostIn& x, const float* __restrict__ Y, const bf16_t* __restrict__ BV, const bf16_t* __restrict__ gg, int row, int lane) {
    const size_t yo = ((size_t)(((row >> 12) * 8 + (lane >> 3)) * 4 + ((lane & 7) >> 1)) * 4096 + (row & 4095)) * 16 + (lane & 1) * 8;
    x.y0 = __builtin_nontemporal_load((const f32x4*)(Y + yo)); x.y1 = __builtin_nontemporal_load((const f32x4*)(Y + yo + 4));
    x.bvw = __builtin_nontemporal_load((const u32x4*)(BV + yo)); x.ggw = __builtin_nontemporal_load((const u32x4*)(gg + (size_t)row * 512 + 8 * lane));
}
__device__ __forceinline__ float sum8(float s) { s = dpp_add<0xB1>(s); s = dpp_add<0x4E>(s); return dpp_add<0x141>(s); }
__device__ __forceinline__ void phase_post(const Params& p, int G, int bid, int tid) {
    unsigned char* ws = p.ws;
    const float* Y = p.out; const bf16_t* BV = (const bf16_t*)(p.out + 16777216); const bf16_t* gg = (const bf16_t*)(ws + WS_GG);
    bf16_t* mix = (bf16_t*)(ws + WS_MIX);
    const int lane = tid & 63, wave = tid >> 6, gw = bid * NWAVES + wave, NGW = G * NWAVES;
    const f32x4 lw0 = *(const f32x4*)(p.in[17] + 8 * lane), lw1 = *(const f32x4*)(p.in[17] + 8 * lane + 4), lb0 = *(const f32x4*)(p.in[18] + 8 * lane), lb1 = *(const f32x4*)(p.in[18] + 8 * lane + 4);
    PostIn nx;
    if (gw < MREAL) post_load(nx, Y, BV, gg, gw, lane);
    for (int row = gw; row < MREAL; row += NGW) {
        const PostIn x = nx;
        if (row + NGW < MREAL) post_load(nx, Y, BV, gg, row + NGW, lane);
        const f32x4 y0 = x.y0, y1 = x.y1; const u32x4 bvw = x.bvw, ggw = x.ggw;
        const float s = sum8((y0[0] + y0[1]) + (y0[2] + y0[3]) + (y1[0] + y1[1]) + (y1[2] + y1[3]));
        const float mean = s * (1.0f / 64.0f);
        const f32x4 d0 = y0 - mean, d1 = y1 - mean;
        const float q = sum8((d0[0] * d0[0] + d0[1] * d0[1]) + (d0[2] * d0[2] + d0[3] * d0[3]) + (d1[0] * d1[0] + d1[1] * d1[1]) + (d1[2] * d1[2] + d1[3] * d1[3]));
        const float rstd = __builtin_amdgcn_rsqf(q * (1.0f / 64.0f) + 64e-5f);
        const f32x4 bv0 = (f32x4){bflo(bvw.x), bfhi(bvw.x), bflo(bvw.y), bfhi(bvw.y)}, bv1 = (f32x4){bflo(bvw.z), bfhi(bvw.z), bflo(bvw.w), bfhi(bvw.w)};
        const f32x4 g0 = (f32x4){bflo(ggw.x), bfhi(ggw.x), bflo(ggw.y), bfhi(ggw.y)}, g1 = (f32x4){bflo(ggw.z), bfhi(ggw.z), bflo(ggw.w), bfhi(ggw.w)};
        const f32x4 o0 = (d0 * rstd * lw0 + lb0 + bv0) * g0, o1 = (d1 * rstd * lw1 + lb1 + bv1) * g1;
        u32x4 w; w.x = pk2(o0[0], o0[1]); w.y = pk2(o0[2], o0[3]); w.z = pk2(o1[0], o1[1]); w.w = pk2(o1[2], o1[3]);
        *(u32x4*)(mix + (size_t)row * 1024 + 512 + 8 * lane) = w;
    }
}

__device__ __forceinline__ void phase_final(const Params& p, int G, int bid, int tid) {
    const float* ss = (const float*)(p.ws + WS_SS) + 3 * MPAD; const float* fn = p.in[24];
    const int lane = tid & 63, wave = tid >> 6, gw = bid * NWAVES + wave, NGW = G * NWAVES;
    f32x4 g[4];
#pragma unroll
    for (int j = 0; j < 4; ++j) g[j] = ((const f32x4*)fn)[lane + 64 * j];
    const bf16_t* xb = (const bf16_t*)(p.ws + WS_XB);
    for (int row = gw * 2; row < MREAL; row += NGW * 2) {
        const float rs0 = pg8::rstd_of(ss[row]), rs1 = pg8::rstd_of(ss[row + 1]);
        f32x4* o = (f32x4*)(p.out + (size_t)row * DM);
        const u32x2* hsrc = (const u32x2*)(xb + (size_t)row * DM);
        u32x2 v0[4], v1[4];
#pragma unroll
        for (int j = 0; j < 4; ++j) { v0[j] = __builtin_nontemporal_load(hsrc + lane + 64 * j); v1[j] = __builtin_nontemporal_load(hsrc + 256 + lane + 64 * j); }
#pragma unroll
        for (int j = 0; j < 4; ++j) { __builtin_nontemporal_store(unpk4(v0[j]) * rs0 * g[j], o + lane + 64 * j); __builtin_nontemporal_store(unpk4(v1[j]) * rs1 * g[j], o + 256 + lane + 64 * j); }
    }
}

#define XB_TMO      128
#define XB_XCNT(j)  (256  + 64 * (j))
#define XB_XSUB(j)  (1280 + 64 * (j))
#define XB_XGEN(j)  (2304 + 64 * (j))
#define XB_TOP      3328
#define XB_TOPGEN   3392
#define XCD_BAR_WORDS 3456
#define XB_SPIN_CAP (1u << 18)

__device__ __forceinline__ unsigned xb_ld(unsigned* p)              { return __hip_atomic_load(p, __ATOMIC_RELAXED, __HIP_MEMORY_SCOPE_AGENT); }
__device__ __forceinline__ unsigned xb_add(unsigned* p, unsigned v) { return __hip_atomic_fetch_add(p, v, __ATOMIC_RELAXED, __HIP_MEMORY_SCOPE_AGENT); }
__device__ __forceinline__ unsigned xb_xcc_id() { return (unsigned)__builtin_amdgcn_s_getreg((3 << 11) | 20) & 0xFu; }
#define XB_SPIN(cond, bar) do { unsigned _sp = 0; while (cond) { __builtin_amdgcn_s_sleep(1); \
    if ((++_sp & 255u) == 0u) { if (xb_ld(&(bar)[XB_TMO])) break; if (_sp > XB_SPIN_CAP) { atomicAdd(&(bar)[XB_TMO], 1u); break; } } } } while (0)

struct XcdBarrier {
    unsigned* bar; unsigned x;
    volatile LAS unsigned* st;
};

__device__ __forceinline__ XcdBarrier xcd_barrier_post(unsigned* bar, volatile LAS unsigned* st) {
    XcdBarrier b; b.bar = bar; b.x = xb_xcc_id(); b.st = st;
    if (threadIdx.x == 0) (void)xb_add(&bar[XB_XCNT(b.x)], 1u);
    return b;
}
__device__ __forceinline__ void xcd_barrier_complete(unsigned* bar, unsigned x, unsigned& nloc, unsigned& nx) {
    const unsigned G = gridDim.x * gridDim.y * gridDim.z;
    unsigned sum, cnt, mine, sp = 0u;
    for (;;) {
        sum = 0u; cnt = 0u; mine = 0u;
#pragma unroll
        for (unsigned j = 0; j < 16; ++j) { const unsigned c = xb_ld(&bar[XB_XCNT(j)]); sum += c; cnt += (c > 0u) ? 1u : 0u; mine = (j == x) ? c : mine; }
        if (sum == G) break;
        __builtin_amdgcn_s_sleep(1);
        if ((++sp & 255u) == 0u) { if (xb_ld(&bar[XB_TMO])) break; if (sp > XB_SPIN_CAP) { atomicAdd(&bar[XB_TMO], 1u); break; } }
    }
    nloc = mine > 0u ? mine : 1u; nx = cnt > 0u ? cnt : 1u;
}

__device__ __forceinline__ void xcd_barrier(const XcdBarrier& b) {
    asm volatile("s_waitcnt vmcnt(0)" ::: "memory");
    __syncthreads();
    if (threadIdx.x == 0) {
        unsigned* bar = b.bar;
        __builtin_amdgcn_s_waitcnt(0);
        unsigned nloc = b.st[0], nx = b.st[1];
        if (nloc == 0u) { xcd_barrier_complete(bar, b.x, nloc, nx); b.st[0] = nloc; b.st[1] = nx; }
        const unsigned old = xb_add(&bar[XB_XSUB(b.x)], 1u);
        const unsigned gen = old / nloc;
        if (old + 1u == (gen + 1u) * nloc) {
            __builtin_amdgcn_fence(__ATOMIC_RELEASE, "agent");
            asm volatile("s_waitcnt vmcnt(0)" ::: "memory");
            const unsigned og = xb_add(&bar[XB_TOP], 1u);
            const unsigned tg = og / nx;
            if (og + 1u == (tg + 1u) * nx) xb_add(&bar[XB_TOPGEN], 1u);
            else XB_SPIN(xb_ld(&bar[XB_TOPGEN]) == tg, bar);
            __builtin_amdgcn_fence(__ATOMIC_ACQUIRE, "agent");
            xb_add(&bar[XB_XGEN(b.x)], 1u);
            asm volatile("s_waitcnt vmcnt(0)" ::: "memory");
        } else {
            XB_SPIN(xb_ld(&bar[XB_XGEN(b.x)]) == gen, bar);
            __builtin_amdgcn_fence(__ATOMIC_ACQUIRE, "agent");
            asm volatile("s_waitcnt vmcnt(0)" ::: "memory");
        }
    }
    __syncthreads();
}

__global__ void __launch_bounds__(NTHREADS, 2) hymba_fwd(Params p) {
    extern __shared__ __attribute__((aligned(16))) unsigned char lds_raw[];
    LAS unsigned char* lds = (LAS unsigned char*)lds_raw;
    cg::grid_group grid = cg::this_grid();
    const int tid0 = threadIdx.x, bid = blockIdx.x, G = gridDim.x;
#define OPQ_TID() ({ int t_ = tid0; asm volatile("" : "+v"(t_)); t_; })
    const int tid = tid0;
    unsigned char* ws = p.ws;
    float* ss = (float*)(ws + WS_SS);
    bf16_t* xb = (bf16_t*)(ws + WS_XB); bf16_t* act = (bf16_t*)(ws + WS_ACT); bf16_t* mix = (bf16_t*)(ws + WS_MIX);


    volatile LAS unsigned* xst = (volatile LAS unsigned*)(lds + 131072 + 64);
    if (tid == 0) { xst[0] = 0u; xst[1] = 0u; }
    __syncthreads();
    const XcdBarrier xbar = xcd_barrier_post((unsigned*)(ws + WS_BAR), xst);
    phase_prologue(p, lds, G, bid, OPQ_TID());
    if (G == 0x7fffffff) grid.sync();
    xcd_barrier(xbar);
    {
        meta_gemm<1>(p, lds, G, bid, OPQ_TID());
        pg8::Gemm g{xb, (const bf16_t*)(ws + WS_WGU1), MREAL, NGU, DM}; pg8::StaticOrder S; S.init(MREAL, NGU, G, bid);
        pg8::EpiSwiglu E{ss, act};
        pg8::gemm_phase<pg8::EpiSwiglu, pg8::StaticOrder, true, true>(lds, g, S, E);
    }
    xcd_barrier(xbar);
    {
        meta_gemm<2>(p, lds, G, bid, OPQ_TID());
        pg8::Gemm g{act, (const bf16_t*)(ws + WS_WD1), MREAL, DM, DFF}; pg8::StaticOrder S; S.init(MREAL, DM, G, bid);
        pg8::EpiResid<1> E{nullptr, nullptr, xb, ss + MPAD, 0.5f};
        pg8::gemm_phase<pg8::EpiResid<1>, pg8::StaticOrder, true, true>(lds, g, S, E);
    }
    xcd_barrier(xbar);
    {
        meta_gemm<3>(p, lds, G, bid, OPQ_TID());
        pg8::Gemm g{xb, (const bf16_t*)(ws + WS_WIN), MREAL, NINP, DM}; pg8::StaticOrder S; S.init(MREAL, NINP, G, bid);
        pg8::EpiProj E{ss + MPAD, mix, (bf16_t*)(ws + WS_KB), (bf16_t*)(ws + WS_VT), (bf16_t*)(ws + WS_PB)};
        pg8::gemm_phase<pg8::EpiProj, pg8::StaticOrder, true, true>(lds, g, S, E);
    }
    xcd_barrier(xbar);
    {
        const int tq = OPQ_TID(), lane = tq & 63, wave = tq >> 6, gw = bid * NWAVES + wave, NGW = G * NWAVES;
        for (int it = gw; it < MREAL / 4; it += NGW) rp_item(p, it >> 2, (it & 3) * 8, 8, lane);
        if (gw < 32) rp_item(p, MREAL / 16, gw, 1, lane);
    }
    xcd_barrier(xbar);
    phase_scan(p, lds, G, bid, OPQ_TID());
    xcd_barrier(xbar);
    phase_post(p, G, bid, OPQ_TID());
    xcd_barrier(xbar);
    {
        pg8::Gemm g{mix, (const bf16_t*)(ws + WS_WOUT), MREAL, DM, DM}; pg8::StaticOrder S; S.init(MREAL, DM, G, bid);
        pg8::EpiResid<1> E{nullptr, nullptr, xb, ss + 2 * MPAD, 1.0f};
        pg8::gemm_phase<pg8::EpiResid<1>, pg8::StaticOrder, true, true>(lds, g, S, E);
    }
    xcd_barrier(xbar);
    {
        pg8::Gemm g{xb, (const bf16_t*)(ws + WS_WGU2), MREAL, NGU, DM}; pg8::StaticOrder S; S.init(MREAL, NGU, G, bid);
        pg8::EpiSwiglu E{ss + 2 * MPAD, act};
        pg8::gemm_phase<pg8::EpiSwiglu, pg8::StaticOrder, true, true>(lds, g, S, E);
    }
    xcd_barrier(xbar);
    {
        pg8::Gemm g{act, (const bf16_t*)(ws + WS_WD2), MREAL, DM, DFF}; pg8::StaticOrder S; S.init(MREAL, DM, G, bid);
        pg8::EpiResid<2> E{nullptr, p.out, xb, ss + 3 * MPAD, 0.5f};
        pg8::gemm_phase<pg8::EpiResid<2>, pg8::StaticOrder, true, true>(lds, g, S, E);
    }
    xcd_barrier(xbar);
    phase_final(p, G, bid, OPQ_TID());
}

extern "C" void kernel_launch(void* const* d_in, const int* in_sizes, int n_in, void* d_out, int out_size, void* d_ws, size_t ws_size, hipStream_t stream) {
    static int grid = 0;
    if (grid == 0) {
        if (n_in != 25 || ws_size < WS_END) { fprintf(stderr, "kernel_launch: unexpected inputs (n_in %d, ws %zu, need %zu)\n", n_in, ws_size, (size_t)WS_END); grid = -1; return; }
        int dev = 0, cus = 0, per_cu = 0;
        (void)hipGetDevice(&dev);
        (void)hipDeviceGetAttribute(&cus, hipDeviceAttributeMultiprocessorCount, dev);
        (void)hipFuncSetAttribute((const void*)hymba_fwd, hipFuncAttributeMaxDynamicSharedMemorySize, LDS_BYTES);
        (void)hipOccupancyMaxActiveBlocksPerMultiprocessor(&per_cu, (const void*)hymba_fwd, NTHREADS, LDS_BYTES);
        if (per_cu < 1) { fprintf(stderr, "kernel_launch: occupancy query says %d blocks per CU\n", per_cu); per_cu = 1; }
        (void)hipGetLastError();
        grid = cus * per_cu;
    }
    if (grid < 0) return;
    (void)hipMemsetAsync((unsigned char*)d_ws + WS_BAR, 0, XCD_BAR_WORDS * 4, stream);
    Params p{};
    for (int i = 0; i < 25; ++i) p.in[i] = (const float*)d_in[i];
    p.out = (float*)d_out; p.ws = (unsigned char*)d_ws;
    void* args[] = {&p};
    hipError_t e = hipLaunchCooperativeKernel((const void*)hymba_fwd, dim3(grid), dim3(NTHREADS), args, LDS_BYTES, stream);
    if (e != hipSuccess) fprintf(stderr, "cooperative launch failed: %s (grid %d)\n", hipGetErrorString(e), grid);
}
```

```cpp
#include <hip/hip_runtime.h>
#include <hip/hip_cooperative_groups.h>
#include <cstdio>
#include <cstdint>
namespace cg = cooperative_groups;
namespace pg8 {
#define PG8_LAS __attribute__((address_space(3)))
typedef unsigned short bf16_t;
typedef short bf16x8 __attribute__((ext_vector_type(8)));
typedef float f32x4 __attribute__((ext_vector_type(4)));
typedef unsigned u32x4 __attribute__((ext_vector_type(4)));
constexpr int BM = 256, BK = 64, HALF = 128, HTB = HALF * BK * 2  , STAGE_BYTES = 8 * HTB, NXCD = 8, WGM = 8;

__host__ __device__ __forceinline__ int lds_byte(int r, int c) { const int st = (r >> 4) * 2 + (c >> 5), rr = r & 15, cc = c & 31, ob = rr * 64 + cc * 2; return st * 1024 + (ob ^ (((ob >> 9) & 1) << 5)); }
__host__ __device__ __forceinline__ void stage_rc(int b, int& R, int& C) { const int st = b / 1024, sb = b % 1024, swz = sb ^ (((sb >> 9) & 1) << 5); R = (st >> 1) * 16 + swz / 64; C = (st & 1) * 32 + (swz % 64) / 2; }
__host__ __device__ __forceinline__ int perm32(int rho) { const int n = rho >> 4, i = rho & 15; return 8 * (i >> 2) + 4 * n + (i & 3); }

struct Unit { int pm, pn; };
struct Gemm { const bf16_t* A; const bf16_t* Bt; int M, N, K; };

struct StaticOrder {
    int nM, nN, nwg, G, c;
    __host__ __device__ void init(int M, int N, int G_, int c_) { nM = M / BM; nN = N / BM; nwg = nM * nN; G = G_; c = c_; }
    __host__ __device__ bool next(int i, Unit& u) const {
        const long L = (long)i * G + c; if (L >= nwg) return false;
        int wgid = (int)L; { const int q = nwg / NXCD, r = nwg % NXCD, xcd = wgid % NXCD, off = wgid / NXCD; wgid = (xcd < r ? xcd * (q + 1) : r * (q + 1) + (xcd - r) * q) + off; }
        const int nig = WGM * nN, gid = wgid / nig, fm = gid * WGM, gsz = (nM - fm) < WGM ? (nM - fm) : WGM;
        u.pm = fm + ((wgid % nig) % gsz); u.pn = (wgid % nig) / gsz; return true;
    }
    __device__ __forceinline__ void a_ready(const Unit&) const {}
    __device__ __forceinline__ void done(const Unit&) const {}
};

__device__ __forceinline__ unsigned cvt_pk_bf16(float lo, float hi) { unsigned r; asm volatile("v_cvt_pk_bf16_f32 %0, %1, %2" : "=v"(r) : "v"(lo), "v"(hi)); return r; }
typedef float f32x2 __attribute__((ext_vector_type(2)));

typedef unsigned u32x2 __attribute__((ext_vector_type(2)));
__device__ __forceinline__ float sum_xor16_32(float x) {
    unsigned u = __builtin_bit_cast(unsigned, x);
    const auto r = __builtin_amdgcn_permlane16_swap(u, u, false, false);
    x = __builtin_bit_cast(float, (unsigned)r[0]) + __builtin_bit_cast(float, (unsigned)r[1]);
    u = __builtin_bit_cast(unsigned, x);
    const auto t = __builtin_amdgcn_permlane32_swap(u, u, false, false);
    return __builtin_bit_cast(float, (unsigned)t[0]) + __builtin_bit_cast(float, (unsigned)t[1]);
}
__device__ __forceinline__ float rstd_of(float ss) { return __builtin_amdgcn_rsqf(ss * (1.0f / 1024.0f) + 1e-6f); }

struct EpiSwiglu {
    static constexpr bool PERM = true, AFTER_DRAIN = false;
    const float* ss; bf16_t* O;
    __device__ __forceinline__ void operator()(const f32x4 (&acc)[2][2][4][2], const Unit& u, int wr, int wc, int fr, int fq) const {
#pragma unroll
        for (int ai = 0; ai < 2; ++ai)
#pragma unroll
            for (int m = 0; m < 4; ++m) {
                const int row = u.pm * BM + ai * HALF + wr * 64 + m * 16 + fr;
                const float rs = rstd_of(ss[row]);
                unsigned w[4];
                const float rl = rs * -1.4426950408889634f, rs2 = rs * rs;
#pragma unroll
                for (int n = 0; n < 2; ++n) {
                    const f32x4 g = acc[ai][0][m][n], gu = acc[ai][0][m][n] * acc[ai][1][m][n];
                    float a[4];
#pragma unroll
                    for (int i = 0; i < 4; ++i) a[i] = gu[i] * (rs2 * __builtin_amdgcn_rcpf(1.0f + __builtin_amdgcn_exp2f(g[i] * rl)));
                    w[2 * n] = cvt_pk_bf16(a[0], a[1]); w[2 * n + 1] = cvt_pk_bf16(a[2], a[3]);
                }
                u32x4 o; o.x = w[0]; o.y = w[1]; o.z = w[2]; o.w = w[3];
                *(u32x4*)(O + (size_t)row * 2816 + u.pn * 128 + wc * 32 + 8 * fq) = o;
            }
    }
};

template <int MODE> struct EpiResid {
    static constexpr bool PERM = true, AFTER_DRAIN = false;
    const float* x; float* h; bf16_t* xb; float* ss; float scale;
    __device__ __forceinline__ void operator()(const f32x4 (&acc)[2][2][4][2], const Unit& u, int wr, int wc, int fr, int fq) const {
#pragma unroll
        for (int ai = 0; ai < 2; ++ai)
#pragma unroll
            for (int m = 0; m < 4; ++m) {
                const int row = u.pm * BM + ai * HALF + wr * 64 + m * 16 + fr;
                bf16_t* rowp = xb + (size_t)row * 1024 + u.pn * BM + wc * 32 + 8 * fq;
                float q = 0.f;
#pragma unroll
                for (int bj = 0; bj < 2; ++bj) {
                    const u32x4 w = *(const u32x4*)(rowp + bj * HALF);
                    const f32x4 b0 = (f32x4){__builtin_bit_cast(float, w.x << 16), __builtin_bit_cast(float, w.x & 0xffff0000u), __builtin_bit_cast(float, w.y << 16), __builtin_bit_cast(float, w.y & 0xffff0000u)};
                    const f32x4 b1 = (f32x4){__builtin_bit_cast(float, w.z << 16), __builtin_bit_cast(float, w.z & 0xffff0000u), __builtin_bit_cast(float, w.w << 16), __builtin_bit_cast(float, w.w & 0xffff0000u)};
                    const f32x4 v0 = b0 + acc[ai][bj][m][0] * scale, v1 = b1 + acc[ai][bj][m][1] * scale;
                    u32x4 o; o.x = cvt_pk_bf16(v0[0], v0[1]); o.y = cvt_pk_bf16(v0[2], v0[3]); o.z = cvt_pk_bf16(v1[0], v1[1]); o.w = cvt_pk_bf16(v1[2], v1[3]);
                    *(u32x4*)(rowp + bj * HALF) = o;
                    q += ((v0[0] * v0[0] + v0[1] * v0[1]) + (v0[2] * v0[2] + v0[3] * v0[3])) + ((v1[0] * v1[0] + v1[1] * v1[1]) + (v1[2] * v1[2] + v1[3] * v1[3]));
                }
                q = sum_xor16_32(q);
                if (fq == 0) atomicAdd(ss + row, q);
            }
    }
};

struct EpiProj {
    static constexpr bool PERM = true, AFTER_DRAIN = false;
    const float* ss; bf16_t* mix; bf16_t* kb; bf16_t* vt; bf16_t* pb;
    __device__ __forceinline__ void operator()(const f32x4 (&acc)[2][2][4][2], const Unit& u, int wr, int wc, int fr, int fq) const {
#pragma unroll
        for (int ai = 0; ai < 2; ++ai)
#pragma unroll
            for (int m = 0; m < 4; ++m) {
                const int row = u.pm * BM + ai * HALF + wr * 64 + m * 16 + fr;
                const float rs = rstd_of(ss[row]);
                const int bb = row >> 12, tt = row & 4095;
#pragma unroll
                for (int bj = 0; bj < 2; ++bj) {
                    const int col = u.pn * BM + bj * HALF + wc * 32 + 8 * fq;
                    const f32x4 v0 = acc[ai][bj][m][0] * rs, v1 = acc[ai][bj][m][1] * rs;
                    u32x4 w; w.x = cvt_pk_bf16(v0[0], v0[1]); w.y = cvt_pk_bf16(v0[2], v0[3]); w.z = cvt_pk_bf16(v1[0], v1[1]); w.w = cvt_pk_bf16(v1[2], v1[3]);
                    if (u.pn < 2) *(u32x4*)(mix + (size_t)row * 1024 + col) = w;
                    else if (u.pn < 4) *(u32x4*)(kb + ((size_t)bb * 4112 + 16 + tt) * 512 + (col - 512)) = w;
                    else if (u.pn < 6) {
                        const int vc = col - 1024, hh = vc >> 6, d0 = vc & 63;
                        bf16_t* p = vt + ((size_t)(bb * 8 + hh) * 64 + d0) * 4128 + 32 + tt;
                        p[0] = (bf16_t)(w.x & 0xffffu); p[4128] = (bf16_t)(w.x >> 16); p[2 * 4128] = (bf16_t)(w.y & 0xffffu); p[3 * 4128] = (bf16_t)(w.y >> 16);
                        p[4 * 4128] = (bf16_t)(w.z & 0xffffu); p[5 * 4128] = (bf16_t)(w.z >> 16); p[6 * 4128] = (bf16_t)(w.w & 0xffffu); p[7 * 4128] = (bf16_t)(w.w >> 16);
                    } else *(u32x4*)(pb + (size_t)row * 1792 + (col - 1536)) = w;
                }
            }
    }
};
template <class Epi, class Sched, bool ALIGN_EPI = false, bool SP2 = false>
__device__ __forceinline__ void gemm_phase(PG8_LAS unsigned char* lds, const Gemm g, const Sched& S, const Epi& E) {
    int tid_ = threadIdx.x; asm volatile("" : "+v"(tid_));
    const int tid = tid_, wid = __builtin_amdgcn_readfirstlane(tid >> 6), lane = tid & 63, wr = wid >> 2, wc = wid & 3, fr = lane & 15, fq = lane >> 4;
    const int K = g.K, nt = K / BK;
    unsigned voffA[2], voffB[2];
#pragma unroll
    for (int i = 0; i < 2; ++i) { int R, C; stage_rc(tid * 16 + i * 8192, R, C); const int Rb = Epi::PERM ? ((R & ~31) + perm32(R & 31)) : R;
        voffA[i] = (unsigned)(R * K + C) * 2u; voffB[i] = (unsigned)(Rb * K + C) * 2u; }
    const size_t kstep = (size_t)(BK * 2);
    const size_t hstep = (size_t)HALF * K * 2;
    const size_t tstep = 2 * hstep;
    const unsigned ldsw = (unsigned)wid * 1024u;
    const int aoff = lds_byte(wr * 64 + fr, fq * 8), boff = lds_byte(wc * 32 + fr, fq * 8);
#define PG8_SA(b, h) (((b) * 2 + (h)) * HTB)
#define PG8_SB(b, h) ((4 + (b) * 2 + (h)) * HTB)
#define PG8_STAGE(bufoff, gbase, voff) do { _Pragma("unroll") for (int _i = 0; _i < 2; ++_i) \
        __builtin_amdgcn_global_load_lds((const unsigned*)((const char*)(gbase) + (voff)[_i]), (PG8_LAS unsigned*)(lds + (bufoff) + ldsw + _i * 8192), 16, 0, 0); } while (0)
#define PG8_LDA(dst, b, h) do { _Pragma("unroll") for (int m = 0; m < 4; ++m) _Pragma("unroll") for (int k = 0; k < 2; ++k) dst[m][k] = *(const PG8_LAS bf16x8*)(lds + PG8_SA(b, h) + aoff + m * 2048 + k * 1024); } while (0)
#define PG8_LDB(dst, b, h) do { _Pragma("unroll") for (int n = 0; n < 2; ++n) _Pragma("unroll") for (int k = 0; k < 2; ++k) dst[n][k] = *(const PG8_LAS bf16x8*)(lds + PG8_SB(b, h) + boff + n * 2048 + k * 1024); } while (0)
#define PG8_MMA(ai, bj, At, Bt) do { __builtin_amdgcn_s_setprio(1); _Pragma("unroll") for (int m = 0; m < 4; ++m) _Pragma("unroll") for (int n = 0; n < 2; ++n) _Pragma("unroll") for (int k = 0; k < 2; ++k) \
        acc[ai][bj][m][n] = __builtin_amdgcn_mfma_f32_16x16x32_bf16(Bt[n][k], At[m][k], acc[ai][bj][m][n], 0, 0, 0); __builtin_amdgcn_s_setprio(0); } while (0)
#define PG8_WAIT_V(n) asm volatile("s_waitcnt vmcnt(" #n ")" ::: "memory")
#define PG8_WAIT_L(n) asm volatile("s_waitcnt lgkmcnt(" #n ")" ::: "memory")
#define PG8_BAR __builtin_amdgcn_s_barrier()
#define PG8_SCHED __builtin_amdgcn_sched_barrier(0)
    Unit cur, nxt; int ui = 0;
    if (!S.next(0, cur)) return;
    f32x4 acc[2][2][4][2];
#pragma unroll
    for (int a = 0; a < 2; ++a)
#pragma unroll
        for (int b = 0; b < 2; ++b)
#pragma unroll
            for (int m = 0; m < 4; ++m)
#pragma unroll
                for (int n = 0; n < 2; ++n) acc[a][b][m][n] = (f32x4){0.f, 0.f, 0.f, 0.f};
    bf16x8 At[4][2], B0[2][2], B1[2][2];
    const char* cA = (const char*)g.A + (size_t)cur.pm * tstep; const char* cB = (const char*)g.Bt + (size_t)cur.pn * tstep;
    S.a_ready(cur);
    if constexpr (SP2) {
        PG8_STAGE(PG8_SB(0, 0), cB, voffB); PG8_STAGE(PG8_SB(0, 1), cB + hstep, voffB); PG8_STAGE(PG8_SA(0, 0), cA, voffA); PG8_STAGE(PG8_SA(0, 1), cA + hstep, voffA);
        if (wr == 1) PG8_BAR;
        PG8_WAIT_V(2); PG8_BAR;
        PG8_STAGE(PG8_SB(1, 0), cB + kstep, voffB); PG8_STAGE(PG8_SA(1, 0), cA + kstep, voffA); PG8_STAGE(PG8_SB(1, 1), cB + hstep + kstep, voffB);
        PG8_WAIT_V(6); PG8_BAR;
    } else {
        PG8_STAGE(PG8_SB(0, 0), cB, voffB); PG8_STAGE(PG8_SA(0, 0), cA, voffA); PG8_STAGE(PG8_SB(0, 1), cB + hstep, voffB); PG8_STAGE(PG8_SA(0, 1), cA + hstep, voffA);
        if (wr == 1) PG8_BAR;
        PG8_WAIT_V(4); PG8_BAR;
        PG8_STAGE(PG8_SB(1, 0), cB + kstep, voffB); PG8_STAGE(PG8_SA(1, 0), cA + kstep, voffA); PG8_STAGE(PG8_SB(1, 1), cB + hstep + kstep, voffB);
        PG8_WAIT_V(6); PG8_BAR;
    }
    for (;;) {
        const bool has_next = S.next(ui + 1, nxt);
        const char* nA = has_next ? (const char*)g.A + (size_t)nxt.pm * tstep : cA; const char* nB = has_next ? (const char*)g.Bt + (size_t)nxt.pn * tstep : cB;
        for (int t = 0; t < nt; t += 2) {
            const bool last = (t == nt - 2);
            const char* a1 = cA + (size_t)(t + 1) * kstep;
            const char* a2 = last ? nA : cA + (size_t)(t + 2) * kstep; const char* b2 = last ? nB : cB + (size_t)(t + 2) * kstep;
            const char* a3 = a2 + kstep; const char* b3 = b2 + kstep;
            if (last && has_next) S.a_ready(nxt);
            if constexpr (SP2) {
            PG8_LDB(B0, 0, 0); PG8_LDB(B1, 0, 1); PG8_SCHED; PG8_LDA(At, 0, 0); PG8_STAGE(PG8_SA(1, 1), a1 + hstep, voffA);
            PG8_WAIT_V(8); PG8_WAIT_L(0); PG8_BAR; PG8_MMA(0, 0, At, B0); PG8_MMA(0, 1, At, B1); PG8_BAR; PG8_SCHED;
            PG8_LDA(At, 0, 1); PG8_STAGE(PG8_SB(0, 0), b2, voffB); PG8_STAGE(PG8_SB(0, 1), b2 + hstep, voffB); PG8_STAGE(PG8_SA(0, 0), a2, voffA);
            PG8_WAIT_V(8); PG8_WAIT_L(0); PG8_BAR; PG8_MMA(1, 0, At, B0); PG8_MMA(1, 1, At, B1); PG8_BAR; PG8_SCHED;
            PG8_LDB(B0, 1, 0); PG8_LDB(B1, 1, 1); PG8_SCHED; PG8_LDA(At, 1, 0); PG8_STAGE(PG8_SA(0, 1), a2 + hstep, voffA);
            PG8_WAIT_V(8); PG8_WAIT_L(0); PG8_BAR; PG8_MMA(0, 0, At, B0); PG8_MMA(0, 1, At, B1); PG8_BAR; PG8_SCHED;
            PG8_LDA(At, 1, 1); PG8_STAGE(PG8_SB(1, 0), b3, voffB); PG8_STAGE(PG8_SB(1, 1), b3 + hstep, voffB); PG8_STAGE(PG8_SA(1, 0), a3, voffA);
            PG8_WAIT_V(8); PG8_WAIT_L(0); PG8_BAR; PG8_MMA(1, 0, At, B0); PG8_MMA(1, 1, At, B1); PG8_BAR; PG8_SCHED;
            } else {
            PG8_LDB(B0, 0, 0); PG8_SCHED; PG8_LDA(At, 0, 0); PG8_STAGE(PG8_SA(1, 1), a1 + hstep, voffA);
            PG8_WAIT_L(8); PG8_BAR; PG8_WAIT_L(0); PG8_MMA(0, 0, At, B0); PG8_BAR; PG8_SCHED;
            PG8_LDB(B1, 0, 1); PG8_STAGE(PG8_SB(0, 0), b2, voffB);
            PG8_BAR; PG8_WAIT_L(0); PG8_MMA(0, 1, At, B1); PG8_BAR;
            PG8_LDA(At, 0, 1); PG8_STAGE(PG8_SA(0, 0), a2, voffA);
            PG8_BAR; PG8_WAIT_L(0); PG8_MMA(1, 0, At, B0); PG8_BAR; PG8_SCHED;
            PG8_STAGE(PG8_SB(0, 1), b2 + hstep, voffB);
            PG8_WAIT_V(6); PG8_BAR; PG8_MMA(1, 1, At, B1); PG8_BAR;
            PG8_LDB(B0, 1, 0); PG8_SCHED; PG8_LDA(At, 1, 0); PG8_STAGE(PG8_SA(0, 1), a2 + hstep, voffA);
            PG8_WAIT_L(8); PG8_BAR; PG8_WAIT_L(0); PG8_MMA(0, 0, At, B0); PG8_BAR; PG8_SCHED;
            PG8_LDB(B1, 1, 1); PG8_STAGE(PG8_SB(1, 0), b3, voffB);
            PG8_BAR; PG8_WAIT_L(0); PG8_MMA(0, 1, At, B1); PG8_BAR;
            PG8_LDA(At, 1, 1); PG8_STAGE(PG8_SA(1, 0), a3, voffA);
            PG8_BAR; PG8_WAIT_L(0); PG8_MMA(1, 0, At, B0); PG8_BAR; PG8_SCHED;
            PG8_STAGE(PG8_SB(1, 1), b3 + hstep, voffB);
            PG8_WAIT_V(6); PG8_BAR; PG8_MMA(1, 1, At, B1); PG8_BAR;
            }
        }
        if constexpr (ALIGN_EPI) { if (wr == 0) PG8_BAR; }
        if constexpr (!Epi::AFTER_DRAIN) { E(acc, cur, wr, wc, fr, fq); S.done(cur); }
        if (!has_next) break;
#pragma unroll
        for (int a = 0; a < 2; ++a)
#pragma unroll
            for (int b = 0; b < 2; ++b)
#pragma unroll
                for (int m = 0; m < 4; ++m)
#pragma unroll
                    for (int n = 0; n < 2; ++n) acc[a][b][m][n] = (f32x4){0.f, 0.f, 0.f, 0.f};
        cur = nxt; cA = nA; cB = nB; ++ui;
        if constexpr (ALIGN_EPI) { if (wr == 1) PG8_BAR; }
    }
    PG8_WAIT_V(0);
    if constexpr (!ALIGN_EPI) { if (wr == 0) PG8_BAR; }
    PG8_BAR;
    if constexpr (Epi::AFTER_DRAIN) { E.fused(acc, cur, wr, wc, fr, fq, lds, wid, lane); S.done(cur); }
#undef PG8_SA
#undef PG8_SB
#undef PG8_STAGE
#undef PG8_LDA
#undef PG8_LDB
#undef PG8_MMA
#undef PG8_WAIT_V
#undef PG8_WAIT_L
#undef PG8_BAR
#undef PG8_SCHED
}
}

#define LAS __attribute__((address_space(3)))
using pg8::bf16_t; using pg8::bf16x8; using pg8::f32x4; using pg8::u32x4; using pg8::u32x2;
typedef float f32x16 __attribute__((ext_vector_type(16)));
constexpr int NWAVES = 8, NTHREADS = 512;
constexpr int MREAL = 32768, MTOK = 32784, MPAD = 33024;
constexpr int DM = 1024, DFF = 2816, NGU = 5632, NIN = 3232, NINP = 3328, PBW = 1792, LK = 4112, VTP = 4128;
constexpr int LDS_BYTES = 135168;

constexpr size_t al4k(size_t x) { return (x + 4095) & ~(size_t)4095; }
constexpr size_t WS_SS = 0;
constexpr size_t WS_LORA = al4k(WS_SS + (size_t)4 * MPAD * 4);
constexpr size_t WS_WGU1 = al4k(WS_LORA + (size_t)512 * 160 * 2);
constexpr size_t WS_WD1 = WS_WGU1 + (size_t)NGU * DM * 2;
constexpr size_t WS_WIN = WS_WD1 + (size_t)DM * DFF * 2;
constexpr size_t WS_WOUT = WS_WIN + (size_t)NINP * DM * 2;
constexpr size_t WS_WGU2 = WS_WOUT + (size_t)DM * DM * 2;
constexpr size_t WS_WD2 = WS_WGU2 + (size_t)NGU * DM * 2;
constexpr size_t WS_XB = al4k(WS_WD2 + (size_t)DM * DFF * 2);
constexpr size_t WS_ACT = al4k(WS_XB + (size_t)MPAD * DM * 2);
constexpr size_t WS_DEC = WS_ACT;
constexpr size_t WS_AA = WS_DEC + (size_t)MTOK * 512 * 4;
constexpr size_t WS_GG = WS_AA + (size_t)MTOK * 512 * 2;
constexpr size_t WS_VT = al4k(WS_GG + (size_t)MTOK * 512 * 2);
constexpr size_t WS_KB = al4k(WS_ACT + (size_t)MPAD * DFF * 2);
constexpr size_t WS_PB = al4k(WS_KB + (size_t)8 * LK * 512 * 2);
constexpr size_t WS_MIX = al4k(WS_PB + (size_t)MPAD * PBW * 2);
constexpr size_t WS_BAR = WS_MIX + (size_t)MPAD * DM * 2;
constexpr size_t WS_END = WS_BAR + 16384;
static_assert(WS_VT + (size_t)64 * 64 * VTP * 2 <= WS_KB, "ACT overlay");
static_assert((size_t)MTOK * 512 * 4 <= (size_t)MPAD * DM * 2 && (size_t)MTOK * 512 * 2 <= (size_t)8 * LK * 512 * 2, "overlays");
static_assert(WS_END <= (size_t)536870912, "workspace");

struct Params { const float* in[25]; float* out; unsigned char* ws; };

__device__ __forceinline__ unsigned f2bf(float f) { unsigned u = __builtin_bit_cast(unsigned, f); return (u + 0x7fffu + ((u >> 16) & 1u)) >> 16; }
typedef float f32x2_t __attribute__((ext_vector_type(2))); typedef __bf16 bf16x2_t __attribute__((ext_vector_type(2)));
__device__ __forceinline__ unsigned pk2(float lo, float hi) { const f32x2_t v = {lo, hi}; const bf16x2_t b = __builtin_convertvector(v, bf16x2_t); return __builtin_bit_cast(unsigned, b); }
__device__ __forceinline__ float bflo(unsigned w) { return __builtin_bit_cast(float, w << 16); }
__device__ __forceinline__ float bfhi(unsigned w) { return __builtin_bit_cast(float, w & 0xffff0000u); }
__device__ __forceinline__ float wave_sum(float v) {
#pragma unroll
    for (int o = 1; o < 64; o <<= 1) v += __shfl_xor(v, o);
    return v;
}
__device__ __forceinline__ float sigmoidf_(float x) { return __builtin_amdgcn_rcpf(1.0f + __expf(-x)); }
__device__ __forceinline__ int prev_row(int row) { if (row >= MREAL) return row == MREAL ? -1 : row - 1; return (row & 4095) == 0 ? (MTOK - 1) : row - 1; }

__device__ __forceinline__ void p0_item(const float* __restrict__ W, int K, int N, bf16_t* WT, LAS float* scr, int item, int lane, const float* __restrict__ gain, int mode, float qscale, int nq) {
    const int nblk = N / 32, kb = item / nblk, nb = item % nblk, k0 = 64 * kb, n0 = 32 * nb;
    const float cs = (n0 < nq) ? qscale : 1.0f;
    const int lr = lane >> 3, lc = 4 * (lane & 7);
    f32x4 wv[8]; float gv[8];
#pragma unroll
    for (int i = 0; i < 8; ++i) { const int kk = 8 * i + lr; wv[i] = __builtin_nontemporal_load((const f32x4*)(W + (size_t)(k0 + kk) * N + n0 + lc)); gv[i] = gain ? gain[k0 + kk] * cs : cs; }
#pragma unroll
    for (int i = 0; i < 8; ++i) { LAS float* d = scr + (8 * i + lr) * 33 + lc; d[0] = wv[i][0] * gv[i]; d[1] = wv[i][1] * gv[i]; d[2] = wv[i][2] * gv[i]; d[3] = wv[i][3] * gv[i]; }
    asm volatile("s_waitcnt lgkmcnt(0)" ::: "memory");
    const int c = lane & 7;
#pragma unroll
    for (int j = 0; j < 4; ++j) { const int n = (lane >> 3) + 8 * j; const LAS float* s = scr + (8 * c) * 33 + n;
        u32x4 o; o.x = pk2(s[0 * 33], s[1 * 33]); o.y = pk2(s[2 * 33], s[3 * 33]); o.z = pk2(s[4 * 33], s[5 * 33]); o.w = pk2(s[6 * 33], s[7 * 33]);
        const int ng = n0 + n; const int orow = mode == 0 ? ng : (((ng >> 7) << 8) + (ng & 127) + (mode == 2 ? 128 : 0));
        *(u32x4*)(WT + (size_t)orow * K + k0 + 8 * c) = o; }
    asm volatile("s_waitcnt lgkmcnt(0)" ::: "memory");
}

__device__ __forceinline__ void phase_prologue(const Params& p, LAS unsigned char* lds, int G, int bid, int tid) {
    const int lane = tid & 63, wave = tid >> 6;
    LAS float* scr = (LAS float*)(lds + wave * 16384);
    const int gw = bid * NWAVES + wave, NGW = G * NWAVES;
    unsigned char* ws = p.ws;
    constexpr int I_GU = (DM / 64) * (DFF / 32), I_D = (DFF / 64) * (DM / 32), I_IN = (DM / 64) * (NIN / 32), I_O = (DM / 64) * (DM / 32);
    constexpr int NITEMS = 4 * I_GU + 2 * I_D + I_IN + I_O;
    for (int it = gw; it < NITEMS; it += NGW) {
        int r = it;
        if (r < I_GU) { p0_item(p.in[3], DM, DFF, (bf16_t*)(ws + WS_WGU1), scr, r, lane, p.in[2], 1, 1.f, 0); continue; } r -= I_GU;
        if (r < I_GU) { p0_item(p.in[4], DM, DFF, (bf16_t*)(ws + WS_WGU1), scr, r, lane, p.in[2], 2, 1.f, 0); continue; } r -= I_GU;
        if (r < I_GU) { p0_item(p.in[21], DM, DFF, (bf16_t*)(ws + WS_WGU2), scr, r, lane, p.in[20], 1, 1.f, 0); continue; } r -= I_GU;
        if (r < I_GU) { p0_item(p.in[22], DM, DFF, (bf16_t*)(ws + WS_WGU2), scr, r, lane, p.in[20], 2, 1.f, 0); continue; } r -= I_GU;
        if (r < I_D) { p0_item(p.in[5], DFF, DM, (bf16_t*)(ws + WS_WD1), scr, r, lane, nullptr, 0, 1.f, 0); continue; } r -= I_D;
        if (r < I_D) { p0_item(p.in[23], DFF, DM, (bf16_t*)(ws + WS_WD2), scr, r, lane, nullptr, 0, 1.f, 0); continue; } r -= I_D;
        if (r < I_IN) { p0_item(p.in[7], DM, NIN, (bf16_t*)(ws + WS_WIN), scr, r, lane, p.in[6], 0, -0.125f * 1.4426950408889634f, 512); continue; } r -= I_IN;
        p0_item(p.in[19], DM, DM, (bf16_t*)(ws + WS_WOUT), scr, r, lane, nullptr, 0, 1.f, 0);
    }
    float* ss = (float*)(ws + WS_SS); bf16_t* xb = (bf16_t*)(ws + WS_XB);
    for (int row0 = gw * 4; row0 < MPAD; row0 += NGW * 4) {
        f32x4 v[4][4];
#pragma unroll
        for (int r = 0; r < 4; ++r) { const int row = row0 + r;
            const float* src = row < MREAL ? p.in[0] + (size_t)row * DM : (row < MTOK ? p.in[1] + (size_t)(row - MREAL) * DM : nullptr);
#pragma unroll
            for (int j = 0; j < 4; ++j) v[r][j] = src ? __builtin_nontemporal_load((const f32x4*)src + lane + 64 * j) : (f32x4){0.f, 0.f, 0.f, 0.f}; }
#pragma unroll
        for (int r = 0; r < 4; ++r) { const int row = row0 + r; float s = 0.f;
#pragma unroll
            for (int j = 0; j < 4; ++j) s += (v[r][j][0] * v[r][j][0] + v[r][j][1] * v[r][j][1]) + (v[r][j][2] * v[r][j][2] + v[r][j][3] * v[r][j][3]);
            s = wave_sum(s);
            u32x2* o = (u32x2*)(xb + (size_t)row * DM);
#pragma unroll
            for (int j = 0; j < 4; ++j) { u32x2 w; w.x = pk2(v[r][j][0], v[r][j][1]); w.y = pk2(v[r][j][2], v[r][j][3]); o[lane + 64 * j] = w; }
            if (lane == 0) { ss[row] = s; ss[MPAD + row] = 0.f; ss[2 * MPAD + row] = 0.f; ss[3 * MPAD + row] = 0.f; } }
    }
    const int gt = bid * NTHREADS + tid, NT = G * NTHREADS;
    bf16_t* wupT = (bf16_t*)(ws + WS_LORA); bf16_t* aupT = wupT + 512 * 32; bf16_t* gupT = aupT + 512 * 32;
    for (int i = gt; i < 512 * 32; i += NT) { const int n = i >> 5, k = i & 31; wupT[i] = (bf16_t)f2bf(p.in[10][k * 512 + n]); aupT[i] = (bf16_t)f2bf(p.in[12][k * 512 + n]); }
    for (int i = gt; i < 512 * 96; i += NT) { const int n = i / 96, k = i % 96; gupT[i] = (bf16_t)f2bf(p.in[13][k * 512 + n]); }
    bf16_t* vt = (bf16_t*)(ws + WS_VT);
    for (int i = gt; i < 4096 * 16; i += NT) vt[(size_t)(i >> 4) * VTP + (i & 15)] = 0;
    unsigned* winpad = (unsigned*)(ws + WS_WIN + (size_t)NIN * DM * 2);
    for (int i = gt; i < (NINP - NIN) * DM / 2; i += NT) winpad[i] = 0u;
}

#define MFMA32(a, b, c) __builtin_amdgcn_mfma_f32_32x32x16_bf16((a), (b), (c), 0, 0, 0)
#define MFMA16(a, b, c) __builtin_amdgcn_mfma_f32_16x16x32_bf16((a), (b), (c), 0, 0, 0)
struct SbState { int active, b, h, m, n; bf16x8 qf[4]; f32x16 o0, o1; float c; bf16x8 nk[4]; };
__device__ __forceinline__ void sb_loadk(bf16x8 (&k)[4], const bf16_t* __restrict__ kbase, int ks, int j) {
    int kp = ks + j; kp = kp < 0 ? 0 : kp;
    const bf16_t* kr = kbase + (size_t)kp * 512;
#pragma unroll
    for (int s = 0; s < 4; ++s) k[s] = *(const bf16x8*)(kr + 16 * s);
}
__device__ __forceinline__ bf16_t* sb_qp(bf16_t* mix, int b, int h, int m, int j) { return mix + ((size_t)b * 4096 + 32 * m + j) * 1024 + h * 64; }
__device__ __forceinline__ const bf16_t* sb_kbase(const bf16_t* kb, int b, int h, int hi) { return kb + (size_t)b * LK * 512 + h * 64 + 8 * hi; }
__device__ __forceinline__ const bf16_t* sb_vbase(const bf16_t* vt, int b, int h, int j, int hi) { return vt + ((size_t)(b * 8 + h) * 64 + j) * VTP + 16 + 4 * hi; }
__device__ __forceinline__ void sb_begin(SbState& st, int b, int h, int m, bf16_t* mix, const bf16_t* __restrict__ kb, const bf16_t* __restrict__ vt, int lane) {
    const int j = lane & 31, hi = lane >> 5;
    const bf16_t* qp = sb_qp(mix, b, h, m, j);
#pragma unroll
    for (int s = 0; s < 4; ++s) st.qf[s] = *(const bf16x8*)(qp + 16 * s + 8 * hi);
#pragma unroll
    for (int i = 0; i < 16; ++i) { st.o0[i] = 0.f; st.o1[i] = 0.f; }
    st.c = 1.0f;
    st.b = b; st.h = h; st.m = m; st.n = 0; st.active = 1;
    sb_loadk(st.nk, sb_kbase(kb, b, h, hi), 16 + 32 * m, j);
}
__device__ __forceinline__ void sb_step(SbState& st, bf16_t* mix, const bf16_t* __restrict__ kb, const bf16_t* __restrict__ vt, int lane) {
    const int j = lane & 31, hi = lane >> 5, m = st.m, n = st.n;
    const int Q0 = 16 + 32 * m;
    {
        const int ks = Q0 - 32 * n;
        const bf16_t* vp = sb_vbase(vt, st.b, st.h, j, hi) + ks;
        u32x2 va[2][2], vb[2][2];
#pragma unroll
        for (int dh = 0; dh < 2; ++dh)
#pragma unroll
            for (int s2 = 0; s2 < 2; ++s2) { va[dh][s2] = *(const u32x2*)(vp + (size_t)dh * 32 * VTP + 16 * s2); vb[dh][s2] = *(const u32x2*)(vp + (size_t)dh * 32 * VTP + 16 * s2 + 8); }
        f32x16 sv;
#pragma unroll
        for (int i = 0; i < 16; ++i) sv[i] = 0.f;
        sv = MFMA32(st.nk[0], st.qf[0], sv); sv = MFMA32(st.nk[1], st.qf[1], sv); sv = MFMA32(st.nk[2], st.qf[2], sv); sv = MFMA32(st.nk[3], st.qf[3], sv);
        float bt[16], kp_[16];
#pragma unroll
        for (int i = 0; i < 16; ++i) {
            const int ko = 8 * (i >> 2) + 4 * hi + (i & 3);
            const float e = __builtin_amdgcn_exp2f(fminf(sv[i], 80.0f));
            const float be = __builtin_amdgcn_rcpf(1.0f + e);
            const bool valid = (ks + ko >= 0) && (n > 0 || ko < j);
            bt[i] = valid ? be : 0.0f; kp_[i] = valid ? e * be : 1.0f;
        }
        float pg[4], og[4];
#pragma unroll
        for (int g = 0; g < 4; ++g) { pg[g] = (kp_[4 * g] * kp_[4 * g + 1]) * (kp_[4 * g + 2] * kp_[4 * g + 3]); og[g] = __shfl_xor(pg[g], 32); }
        float at[16]; float cc = st.c;
#pragma unroll
        for (int g = 3; g >= 0; --g) {
            float base = hi ? cc : cc * og[g];
#pragma unroll
            for (int r = 3; r >= 0; --r) { at[4 * g + r] = bt[4 * g + r] * base; base *= kp_[4 * g + r]; }
            cc *= pg[g] * og[g];
        }
        st.c = cc;
        bf16x8 pf[2];
#pragma unroll
        for (int s2 = 0; s2 < 2; ++s2) { u32x4 w; w.x = pk2(at[8 * s2], at[8 * s2 + 1]); w.y = pk2(at[8 * s2 + 2], at[8 * s2 + 3]); w.z = pk2(at[8 * s2 + 4], at[8 * s2 + 5]); w.w = pk2(at[8 * s2 + 6], at[8 * s2 + 7]); pf[s2] = __builtin_bit_cast(bf16x8, w); }
#pragma unroll
        for (int s2 = 0; s2 < 2; ++s2) {
            u32x4 a0; a0.x = va[0][s2].x; a0.y = va[0][s2].y; a0.z = vb[0][s2].x; a0.w = vb[0][s2].y;
            u32x4 a1; a1.x = va[1][s2].x; a1.y = va[1][s2].y; a1.z = vb[1][s2].x; a1.w = vb[1][s2].y;
            st.o0 = MFMA32(__builtin_bit_cast(bf16x8, a0), pf[s2], st.o0);
            st.o1 = MFMA32(__builtin_bit_cast(bf16x8, a1), pf[s2], st.o1);
        }
    }
    st.n = n + 1;
    if (n + 1 > m + 1 || __all(st.c < 1e-24f)) {
        bf16_t* qp = sb_qp(mix, st.b, st.h, m, j);
#pragma unroll
        for (int g = 0; g < 4; ++g) {
            u32x2 w; w.x = pk2(st.o0[4 * g], st.o0[4 * g + 1]); w.y = pk2(st.o0[4 * g + 2], st.o0[4 * g + 3]); *(u32x2*)(qp + 8 * g + 4 * hi) = w;
            u32x2 w1; w1.x = pk2(st.o1[4 * g], st.o1[4 * g + 1]); w1.y = pk2(st.o1[4 * g + 2], st.o1[4 * g + 3]); *(u32x2*)(qp + 32 + 8 * g + 4 * hi) = w1;
        }
        st.active = 0;
    } else sb_loadk(st.nk, sb_kbase(kb, st.b, st.h, hi), Q0 - 32 * (n + 1), j);
}
__device__ __forceinline__ void sb_advance(SbState& st, int& next, int stride, bf16_t* mix, const bf16_t* kb, const bf16_t* vt, int lane) {
    if (!st.active) { if (next < 8192) { const int uu = 8191 - next; next += stride; sb_begin(st, uu >> 10, (uu >> 7) & 7, uu & 127, mix, kb, vt, lane); } }
    else sb_step(st, mix, kb, vt, lane);
}

template <int FN> __device__ __forceinline__ bf16x8 rp_frag(const bf16_t* __restrict__ pb, int row, int prow, int col, const float* __restrict__ mu) {
    const u32x4 cur = *(const u32x4*)(pb + (size_t)row * PBW + col);
    u32x4 prv = (u32x4){0u, 0u, 0u, 0u};
    if (prow >= 0) prv = *(const u32x4*)(pb + (size_t)prow * PBW + col);
    const f32x4 m0 = *(const f32x4*)(mu + col), m1 = *(const f32x4*)(mu + col + 4);
    float x[8];
#pragma unroll
    for (int i = 0; i < 4; ++i) {
        const float c0 = bflo(cur[i]), c1 = bfhi(cur[i]), p0 = bflo(prv[i]), p1 = bfhi(prv[i]);
        const float mu0 = (i < 2) ? m0[2 * i] : m1[2 * i - 4], mu1 = (i < 2) ? m0[2 * i + 1] : m1[2 * i - 3];
        x[2 * i] = c0 + (p0 - c0) * mu0; x[2 * i + 1] = c1 + (p1 - c1) * mu1;
    }
#pragma unroll
    for (int i = 0; i < 8; ++i) {
        if (FN == 1) x[i] = 1.0f - 2.0f * __builtin_amdgcn_rcpf(__expf(2.0f * x[i]) + 1.0f);
        if (FN == 2) x[i] = sigmoidf_(x[i]);
    }
    u32x4 o; o.x = pk2(x[0], x[1]); o.y = pk2(x[2], x[3]); o.z = pk2(x[4], x[5]); o.w = pk2(x[6], x[7]);
    return __builtin_bit_cast(bf16x8, o);
}
struct RpW { bf16x8 Aw, Aa, Ag0, Ag1, Ag2; f32x4 w0v, a0v; };
__device__ __forceinline__ void rp_wload(RpW& w, const bf16_t* __restrict__ wupT, const bf16_t* __restrict__ aupT, const bf16_t* __restrict__ gupT, const float* __restrict__ w0, const float* __restrict__ a0, int cb, int n, int kq) {
    const int col = 16 * cb + n, oc = 16 * cb + 4 * kq;
    w.Aw = *(const bf16x8*)(wupT + col * 32 + 8 * kq); w.Aa = *(const bf16x8*)(aupT + col * 32 + 8 * kq);
    w.Ag0 = *(const bf16x8*)(gupT + col * 96 + 8 * kq); w.Ag1 = *(const bf16x8*)(gupT + col * 96 + 32 + 8 * kq); w.Ag2 = *(const bf16x8*)(gupT + col * 96 + 64 + 8 * kq);
    w.w0v = *(const f32x4*)(w0 + oc); w.a0v = *(const f32x4*)(a0 + oc);
}
__device__ __forceinline__ void rp_item(const Params& p, int tg, int cb0, int ncb, int lane) {
    unsigned char* ws = p.ws;
    const bf16_t* pb = (const bf16_t*)(ws + WS_PB);
    const bf16_t* wupT = (const bf16_t*)(ws + WS_LORA); const bf16_t* aupT = wupT + 512 * 32; const bf16_t* gupT = aupT + 512 * 32;
    float* dec = (float*)(ws + WS_DEC); bf16_t* aa = (bf16_t*)(ws + WS_AA); bf16_t* gg = (bf16_t*)(ws + WS_GG);
    const int n = lane & 15, kq = lane >> 4, row = tg * 16 + n, prow = prev_row(row);
    const float* mu = p.in[8];
    const bf16x8 Bw = rp_frag<1>(pb, row, prow, 1536 + 8 * kq, mu), Ba = rp_frag<0>(pb, row, prow, 1568 + 8 * kq, mu);
    const bf16x8 Bg0 = rp_frag<2>(pb, row, prow, 1600 + 8 * kq, mu), Bg1 = rp_frag<2>(pb, row, prow, 1632 + 8 * kq, mu), Bg2 = rp_frag<2>(pb, row, prow, 1664 + 8 * kq, mu);
    const float* w0 = p.in[9]; const float* a0 = p.in[11];
    RpW nw; rp_wload(nw, wupT, aupT, gupT, w0, a0, cb0, n, kq);
    for (int cb = cb0; cb < cb0 + ncb; ++cb) {
        const RpW cw = nw;
        if (cb + 1 < cb0 + ncb) rp_wload(nw, wupT, aupT, gupT, w0, a0, cb + 1, n, kq);
        const bf16x8 Aw = cw.Aw, Aa = cw.Aa, Ag0 = cw.Ag0, Ag1 = cw.Ag1, Ag2 = cw.Ag2;
        const f32x4 z = (f32x4){0.f, 0.f, 0.f, 0.f};
        const f32x4 Dw = MFMA16(Aw, Bw, z), Da = MFMA16(Aa, Ba, z);
        f32x4 Dg = MFMA16(Ag0, Bg0, z); Dg = MFMA16(Ag1, Bg1, Dg); Dg = MFMA16(Ag2, Bg2, Dg);
        const int oc = 16 * cb + 4 * kq;
        const f32x4 w0v = cw.w0v, a0v = cw.a0v;
        f32x4 dv; float av[4];
#pragma unroll
        for (int r = 0; r < 4; ++r) { dv[r] = __expf(-0.6065306597126334f * sigmoidf_(Dw[r] + w0v[r])); av[r] = sigmoidf_(Da[r] + a0v[r]); }
        *(f32x4*)(dec + (size_t)row * 512 + oc) = dv;
        u32x2 wa; wa.x = pk2(av[0], av[1]); wa.y = pk2(av[2], av[3]); *(u32x2*)(aa + (size_t)row * 512 + oc) = wa;
        u32x2 wg; wg.x = pk2(Dg[0], Dg[1]); wg.y = pk2(Dg[2], Dg[3]); *(u32x2*)(gg + (size_t)row * 512 + oc) = wg;
    }
}


template <int MODE> __device__ __forceinline__ void meta_gemm(const Params& p, LAS unsigned char* lds, int G, int bid, int tid) {
    unsigned char* ws = p.ws;
    const int lane = tid & 63, wave = tid >> 6, n = lane & 15, kq = lane >> 4;
    constexpr int K = (MODE == 2) ? DFF : DM, KW = K / 8, NIT = (MODE == 1) ? NGU / 32 : (MODE == 2 ? DM / 16 : NINP / 16);
    const bf16_t* A = (MODE == 2) ? (const bf16_t*)(ws + WS_ACT) : (const bf16_t*)(ws + WS_XB);
    const bf16_t* W = (const bf16_t*)(ws + (MODE == 1 ? WS_WGU1 : (MODE == 2 ? WS_WD1 : WS_WIN)));
    float* ss = (float*)(ws + WS_SS);
    LAS f32x4* part = (LAS f32x4*)lds;
    constexpr int NUN3 = (MREAL / 256) * (NINP / 256);
    const int rem3 = (MODE == 3) ? NUN3 % G : 0;
    const int first = (rem3 > 0) ? bid - rem3 : bid, stride = (rem3 > 0) ? G - rem3 : G;
    for (int it = first; it < NIT; it += stride) {
        if (it < 0) break;
        const bf16_t* ap = A + (size_t)(MREAL + n) * K + wave * KW + 8 * kq;
        const int wrow = (MODE == 1) ? ((((16 * it) >> 7) << 8) + ((16 * it) & 127)) : 16 * it;
        const bf16_t* wp = W + (size_t)(wrow + n) * K + wave * KW + 8 * kq;
        f32x4 acc0 = (f32x4){0.f, 0.f, 0.f, 0.f}, acc1 = acc0;
#pragma unroll
        for (int ks = 0; ks < KW / 32; ++ks) {
            const bf16x8 a = *(const bf16x8*)(ap + 32 * ks);
            acc0 = MFMA16(*(const bf16x8*)(wp + 32 * ks), a, acc0);
            if (MODE == 1) acc1 = MFMA16(*(const bf16x8*)(wp + (size_t)128 * K + 32 * ks), a, acc1);
        }
        part[wave * 64 + lane] = acc0;
        if (MODE == 1) part[512 + wave * 64 + lane] = acc1;
        __syncthreads();
        if (wave == 0) {
            f32x4 s0 = part[lane], s1 = (f32x4){0.f, 0.f, 0.f, 0.f};
#pragma unroll
            for (int w = 1; w < 8; ++w) s0 += part[w * 64 + lane];
            if (MODE == 1) { s1 = part[512 + lane];
#pragma unroll
                for (int w = 1; w < 8; ++w) s1 += part[512 + w * 64 + lane]; }
            const int row = MREAL + n;
            if (MODE == 1) {
                const float rs = pg8::rstd_of(ss[row]);
                float a[4];
#pragma unroll
                for (int r = 0; r < 4; ++r) { const float g = s0[r] * rs; a[r] = g * __builtin_amdgcn_rcpf(1.0f + __expf(-g)) * (s1[r] * rs); }
                u32x2 w; w.x = pk2(a[0], a[1]); w.y = pk2(a[2], a[3]);
                *(u32x2*)((bf16_t*)(ws + WS_ACT) + (size_t)row * DFF + 16 * it + 4 * kq) = w;
            } else if (MODE == 2) {
                const int col = 16 * it + 4 * kq;
                const f32x4 b = *(const f32x4*)(p.in[1] + (size_t)n * DM + col);
                const f32x4 v = b + s0 * 0.5f;
                u32x2 w; w.x = pk2(v[0], v[1]); w.y = pk2(v[2], v[3]);
                *(u32x2*)((bf16_t*)(ws + WS_XB) + (size_t)row * DM + col) = w;
                float q = (v[0] * v[0] + v[1] * v[1]) + (v[2] * v[2] + v[3] * v[3]);
                q += __shfl_xor(q, 16); q += __shfl_xor(q, 32);
                if (kq == 0) atomicAdd(ss + MPAD + row, q);
            } else {
                const int col = 16 * it + 4 * kq;
                const float rs = pg8::rstd_of(ss[MPAD + row]);
                const f32x4 v = s0 * rs;
                u32x2 w; w.x = pk2(v[0], v[1]); w.y = pk2(v[2], v[3]);
                if (col >= 1536) *(u32x2*)((bf16_t*)(ws + WS_PB) + (size_t)row * PBW + (col - 1536)) = w;
                else if (col >= 1024) {
                    const int vc = col - 1024, hh = vc >> 6, d0 = vc & 63;
                    const bf16_t e0 = (bf16_t)(w.x & 0xffffu), e1 = (bf16_t)(w.x >> 16), e2 = (bf16_t)(w.y & 0xffffu), e3 = (bf16_t)(w.y >> 16);
                    for (int b2 = 0; b2 < 8; ++b2) { bf16_t* o = (bf16_t*)(ws + WS_VT) + ((size_t)(b2 * 8 + hh) * 64 + d0) * VTP + 16 + n; o[0] = e0; o[VTP] = e1; o[2 * VTP] = e2; o[3 * VTP] = e3; }
                } else if (col >= 512) {
                    for (int b2 = 0; b2 < 8; ++b2) *(u32x2*)((bf16_t*)(ws + WS_KB) + ((size_t)b2 * LK + n) * 512 + (col - 512)) = w;
                }
            }
        }
        __syncthreads();
    }
}

template <int CTRL> __device__ __forceinline__ float dpp_mov(float x) { return __builtin_bit_cast(float, __builtin_amdgcn_update_dpp(0, __builtin_bit_cast(int, x), CTRL, 0xf, 0xf, false)); }
template <int CTRL> __device__ __forceinline__ float dpp_add(float x) { return x + dpp_mov<CTRL>(x); }
__device__ __forceinline__ float row16_sum(float x) { x = dpp_add<0x128>(x); x = dpp_add<0x124>(x); x = dpp_add<0x122>(x); x = dpp_add<0x121>(x); return x; }
constexpr int SC_T = 32, SC_NCH = (LK + SC_T - 1) / SC_T, SC_TOKF = 6 * 64 + 4, SC_BUF = SC_T * SC_TOKF * 4;
constexpr int SC_VT = 2 * SC_BUF + 2 * SC_T * 16 * 4, SC_VTB = 16 * SC_T * 4;
constexpr int SC_OUT = 2 * SC_BUF, SC_OUTB = SC_T * 16 * 4;
#define SC_BARRIER() do { asm volatile("s_waitcnt lgkmcnt(0)" ::: "memory"); __builtin_amdgcn_s_barrier(); asm volatile("" ::: "memory"); } while (0)
__device__ __forceinline__ int seq_row(int b, int s) { return s < 16 ? MREAL + s : b * 4096 + s - 16; }
struct ScRaw { u32x2 r, k, v, rp, kp, vp, a; f32x4 d; };
__device__ __forceinline__ void sc_load(ScRaw& w, const bf16_t* __restrict__ pb, const float* __restrict__ dec, const bf16_t* __restrict__ aa, int b, int s, int col) {
    s = s < LK ? s : LK - 1;
    const int row = seq_row(b, s), prow = prev_row(row);
    const bf16_t* pr = pb + (size_t)row * PBW + col;
    w.r = *(const u32x2*)(pr); w.k = *(const u32x2*)(pr + 512); w.v = *(const u32x2*)(pr + 1024);
    w.rp = (u32x2){0u, 0u}; w.kp = (u32x2){0u, 0u}; w.vp = (u32x2){0u, 0u};
    if (prow >= 0) { const bf16_t* pp = pb + (size_t)prow * PBW + col; w.rp = *(const u32x2*)(pp); w.kp = *(const u32x2*)(pp + 512); w.vp = *(const u32x2*)(pp + 1024); }
    w.d = *(const f32x4*)(dec + (size_t)row * 512 + col);
    w.a = *(const u32x2*)(aa + (size_t)row * 512 + col);
}
__device__ __forceinline__ f32x4 unpk4(u32x2 w) { return (f32x4){bflo(w.x), bfhi(w.x), bflo(w.y), bfhi(w.y)}; }
__device__ __forceinline__ f32x4 sc_produce(const ScRaw& w, LAS float* tokp, int cg, f32x4 mur, f32x4 muk, f32x4 muv, f32x4 kkw, f32x4 kaw, f32x4 rkw, LAS float* vtp, bool mine) {
    const f32x4 r0 = unpk4(w.r), k0 = unpk4(w.k), v0 = unpk4(w.v);
    const f32x4 r = r0 + (unpk4(w.rp) - r0) * mur, k = k0 + (unpk4(w.kp) - k0) * muk, v = v0 + (unpk4(w.vp) - v0) * muv;
    const f32x4 a = unpk4(w.a);
    f32x4 kk = k * kkw;
    float ssq = (kk[0] * kk[0] + kk[1] * kk[1]) + (kk[2] * kk[2] + kk[3] * kk[3]);
    ssq = row16_sum(ssq);
    const float inv = __builtin_amdgcn_rsqf(fmaxf(ssq, 1e-24f));
    kk = kk * inv;
    const f32x4 k2 = k * (1.0f + (a - 1.0f) * kaw);
    const f32x4 t = r * k2 * rkw;
    float bs = (t[0] + t[1]) + (t[2] + t[3]);
    bs = row16_sum(bs);
    *(LAS f32x4*)(tokp + 0 * 64 + 4 * cg) = r;
    *(LAS f32x4*)(tokp + 1 * 64 + 4 * cg) = w.d;
    *(LAS f32x4*)(tokp + 2 * 64 + 4 * cg) = k2;
    *(LAS f32x4*)(tokp + 3 * 64 + 4 * cg) = -kk;
    *(LAS f32x4*)(tokp + 4 * 64 + 4 * cg) = kk * a;
    if (mine) { vtp[0] = v[0]; vtp[SC_T] = v[1]; vtp[2 * SC_T] = v[2]; vtp[3 * SC_T] = v[3]; }
    return v * bs;
}
typedef float f32x2v __attribute__((ext_vector_type(2)));
struct ScStep { f32x4 r, w, k2, nkk, kka; };
__device__ __forceinline__ void sc_fetch(ScStep& x, const LAS float* tp, int c4, int irow) {
    x.r = *(const LAS f32x4*)(tp + c4); x.w = *(const LAS f32x4*)(tp + 64 + c4); x.k2 = *(const LAS f32x4*)(tp + 128 + c4);
    x.nkk = *(const LAS f32x4*)(tp + 192 + c4); x.kka = *(const LAS f32x4*)(tp + 256 + c4);
}
__device__ __forceinline__ void phase_scan(const Params& p, LAS unsigned char* lds, int G, int bid, int tid) {
    unsigned char* ws = p.ws;
    const bf16_t* pb = (const bf16_t*)(ws + WS_PB); const float* dec = (const float*)(ws + WS_DEC); const bf16_t* aa = (const bf16_t*)(ws + WS_AA);
    float* Y = p.out; bf16_t* BV = (bf16_t*)(p.out + 16777216);
    const int lane = tid & 63, wave = tid >> 6;
    if (wave >= 4) {
        bf16_t* mix = (bf16_t*)(ws + WS_MIX); const bf16_t* kbuf = (const bf16_t*)(ws + WS_KB); const bf16_t* vtbuf = (const bf16_t*)(ws + WS_VT);
        SbState sb; sb.active = 0; int sb_next = bid * 4 + (wave - 4); const int sb_stride = G * 4;
        for (int unit = bid; unit < 256; unit += G) {
            const int hd = (unit & 7) * 8 + (unit >> 5), rq = (unit >> 3) & 3, b = hd >> 3, h = hd & 7;
            const int pt = tid - 256, tl = pt >> 4, cg = pt & 15, col = h * 64 + 4 * cg;
            const bool mine = (cg >> 2) == rq;
            const size_t obase = (size_t)(hd * 4 + rq) * 4096;
            ScRaw n0, n1;
            sc_load(n0, pb, dec, aa, b, tl, col); sc_load(n1, pb, dec, aa, b, tl + 16, col);
            for (int ch = 0; ch <= SC_NCH + 1; ++ch) {
                if (ch >= 2 && pt < 128) {
                    const int cc = ch - 2, t = pt >> 2, s = cc * SC_T + t;
                    if (s >= 16 && s < LK) {
                        const f32x4 yv = *(const LAS f32x4*)(lds + SC_OUT + (cc & 1) * SC_OUTB + (t * 16 + 4 * (pt & 3)) * 4);
                        *(f32x4*)(Y + (obase + (s - 16)) * 16 + 4 * (pt & 3)) = yv;
                    }
                }
                if (ch < SC_NCH) {
                    const f32x4 mur = *(const f32x4*)(p.in[8] + col), muk = *(const f32x4*)(p.in[8] + 512 + col), muv = *(const f32x4*)(p.in[8] + 1024 + col);
                    const f32x4 kkw = *(const f32x4*)(p.in[14] + col), kaw = *(const f32x4*)(p.in[15] + col), rkw = *(const f32x4*)(p.in[16] + col);
                    LAS float* buf = (LAS float*)(lds + (ch & 1) * SC_BUF); LAS float* vtb = (LAS float*)(lds + SC_VT + (ch & 1) * SC_VTB);
                    const int s0 = ch * SC_T + tl, s1 = s0 + 16;
                    {
                        const ScRaw c0 = n0;
                        if (ch + 1 < SC_NCH) sc_load(n0, pb, dec, aa, b, (ch + 1) * SC_T + tl, col);
                        const f32x4 bv0 = sc_produce(c0, buf + tl * SC_TOKF, cg, mur, muk, muv, kkw, kaw, rkw, vtb + (4 * (cg & 3)) * SC_T + tl, mine);
                        if (mine && s0 >= 16 && s0 < LK) { u32x2 w; w.x = pk2(bv0[0], bv0[1]); w.y = pk2(bv0[2], bv0[3]); *(u32x2*)(BV + (obase + (s0 - 16)) * 16 + 4 * (cg & 3)) = w; }
                    }
                    {
                        const ScRaw c1 = n1;
                        if (ch + 1 < SC_NCH) sc_load(n1, pb, dec, aa, b, (ch + 1) * SC_T + tl + 16, col);
                        const f32x4 bv1 = sc_produce(c1, buf + (tl + 16) * SC_TOKF, cg, mur, muk, muv, kkw, kaw, rkw, vtb + (4 * (cg & 3)) * SC_T + tl + 16, mine);
                        if (mine && s1 >= 16 && s1 < LK) { u32x2 w; w.x = pk2(bv1[0], bv1[1]); w.y = pk2(bv1[2], bv1[3]); *(u32x2*)(BV + (obase + (s1 - 16)) * 16 + 4 * (cg & 3)) = w; }
                    }
                }
                sb_advance(sb, sb_next, sb_stride, mix, kbuf, vtbuf, lane);
                SC_BARRIER();
            }
        }
        while (sb.active || sb_next < 8192) sb_advance(sb, sb_next, sb_stride, mix, kbuf, vtbuf, lane);
    } else {
        for (int unit = bid; unit < 256; unit += G) {
            const int rq = (unit >> 3) & 3;
            const int rg = lane >> 4, c = lane & 15, c4 = 4 * c, irow = rq * 16 + wave * 4 + rg;
            const bool odd = c & 1, hi2 = (c >> 1) & 1;
            f32x4 S = (f32x4){0.f, 0.f, 0.f, 0.f};
            for (int ch = 0; ch <= SC_NCH + 1; ++ch) {
                if (ch >= 1 && ch <= SC_NCH) {
                    const int cc = ch - 1;
                    const LAS float* buf = (const LAS float*)(lds + (cc & 1) * SC_BUF);
                    LAS float* outp = (LAS float*)(lds + SC_OUT + (cc & 1) * SC_OUTB) + wave * 4 + rg;
                    const int s0 = cc * SC_T, ns = (LK - s0) < SC_T ? (LK - s0) : SC_T;
                    const LAS float* vrow = (const LAS float*)(lds + SC_VT + (cc & 1) * SC_VTB) + (wave * 4 + rg) * SC_T;
                    ScStep nx; sc_fetch(nx, buf, c4, irow); f32x4 nv4 = *(const LAS f32x4*)(vrow);
                    for (int t4 = 0; t4 < ns; t4 += 4) {
                        const f32x4 v4 = nv4; nv4 = *(const LAS f32x4*)(vrow + ((t4 + 4) < SC_T ? (t4 + 4) : 0));
                        float yp[4];
#pragma unroll
                        for (int u = 0; u < 4; ++u) {
                            const ScStep x = nx;
                            const int tn = (t4 + u + 1) < SC_T ? (t4 + u + 1) : (SC_T - 1);
                            sc_fetch(nx, buf + tn * SC_TOKF, c4, irow);
                            f32x2v q = __builtin_shufflevector(S, S, 0, 1) * __builtin_shufflevector(x.nkk, x.nkk, 0, 1);
                            q = __builtin_shufflevector(S, S, 2, 3) * __builtin_shufflevector(x.nkk, x.nkk, 2, 3) + q;
                            const float sa = row16_sum(q[0] + q[1]);
                            S = (S * x.w + x.k2 * v4[u]) + x.kka * sa;
                            f32x2v qy = __builtin_shufflevector(S, S, 0, 1) * __builtin_shufflevector(x.r, x.r, 0, 1);
                            qy = __builtin_shufflevector(S, S, 2, 3) * __builtin_shufflevector(x.r, x.r, 2, 3) + qy;
                            yp[u] = qy[0] + qy[1];
                        }
                        const float z01 = (odd ? yp[1] : yp[0]) + dpp_mov<0xB1>(odd ? yp[0] : yp[1]);
                        const float z23 = (odd ? yp[3] : yp[2]) + dpp_mov<0xB1>(odd ? yp[2] : yp[3]);
                        float z = (hi2 ? z23 : z01) + dpp_mov<0x4E>(hi2 ? z01 : z23);
                        z = dpp_add<0x128>(z); z = dpp_add<0x124>(z);
                        outp[(t4 + (c & 3)) * 16] = z;
                    }
                }
                SC_BARRIER();
            }
        }
    }
}

struct PostIn { f32x4 y0, y1; u32x4 bvw, ggw; };
__device__ __forceinline__ void post_load(PostIn& x, const float* __restrict__ Y, const bf16_t* __restrict__ BV, const bf16_t* __restrict__ gg, int row, int lane) {
    const size_t yo = ((size_t)(((row >> 12) * 8 + (lane >> 3)) * 4 + ((lane & 7) >> 1)) * 4096 + (row & 4095)) * 16 + (lane & 1) * 8;
    x.y0 = *(const f32x4*)(Y + yo); x.y1 = *(const f32x4*)(Y + yo + 4);
    x.bvw = *(const u32x4*)(BV + yo); x.ggw = *(const u32x4*)(gg + (size_t)row * 512 + 8 * lane);
}
__device__ __forceinline__ float sum8(float s) { s = dpp_add<0xB1>(s); s = dpp_add<0x4E>(s); return dpp_add<0x141>(s); }
__device__ __forceinline__ void phase_post(const Params& p, int G, int bid, int tid) {
    unsigned char* ws = p.ws;
    const float* Y = p.out; const bf16_t* BV = (const bf16_t*)(p.out + 16777216); const bf16_t* gg = (const bf16_t*)(ws + WS_GG);
    bf16_t* mix = (bf16_t*)(ws + WS_MIX);
    const int lane = tid & 63, wave = tid >> 6, gw = bid * NWAVES + wave, NGW = G * NWAVES;
    const f32x4 lw0 = *(const f32x4*)(p.in[17] + 8 * lane), lw1 = *(const f32x4*)(p.in[17] + 8 * lane + 4), lb0 = *(const f32x4*)(p.in[18] + 8 * lane), lb1 = *(const f32x4*)(p.in[18] + 8 * lane + 4);
    PostIn nx;
    if (gw < MREAL) post_load(nx, Y, BV, gg, gw, lane);
    for (int row = gw; row < MREAL; row += NGW) {
        const PostIn x = nx;
        if (row + NGW < MREAL) post_load(nx, Y, BV, gg, row + NGW, lane);
        const f32x4 y0 = x.y0, y1 = x.y1; const u32x4 bvw = x.bvw, ggw = x.ggw;
        const float s = sum8((y0[0] + y0[1]) + (y0[2] + y0[3]) + (y1[0] + y1[1]) + (y1[2] + y1[3]));
        const float mean = s * (1.0f / 64.0f);
        const f32x4 d0 = y0 - mean, d1 = y1 - mean;
        const float q = sum8((d0[0] * d0[0] + d0[1] * d0[1]) + (d0[2] * d0[2] + d0[3] * d0[3]) + (d1[0] * d1[0] + d1[1] * d1[1]) + (d1[2] * d1[2] + d1[3] * d1[3]));
        const float rstd = __builtin_amdgcn_rsqf(q * (1.0f / 64.0f) + 64e-5f);
        const f32x4 bv0 = (f32x4){bflo(bvw.x), bfhi(bvw.x), bflo(bvw.y), bfhi(bvw.y)}, bv1 = (f32x4){bflo(bvw.z), bfhi(bvw.z), bflo(bvw.w), bfhi(bvw.w)};
        const f32x4 g0 = (f32x4){bflo(ggw.x), bfhi(ggw.x), bflo(ggw.y), bfhi(ggw.y)}, g1 = (f32x4){bflo(ggw.z), bfhi(ggw.z), bflo(ggw.w), bfhi(ggw.w)};
        const f32x4 o0 = (d0 * rstd * lw0 + lb0 + bv0) * g0, o1 = (d1 * rstd * lw1 + lb1 + bv1) * g1;
        u32x4 w; w.x = pk2(o0[0], o0[1]); w.y = pk2(o0[2], o0[3]); w.z = pk2(o1[0], o1[1]); w.w = pk2(o1[2], o1[3]);
        *(u32x4*)(mix + (size_t)row * 1024 + 512 + 8 * lane) = w;
    }
}

__device__ __forceinline__ void phase_final(const Params& p, int G, int bid, int tid) {
    const float* ss = (const float*)(p.ws + WS_SS) + 3 * MPAD; const float* fn = p.in[24];
    const int lane = tid & 63, wave = tid >> 6, gw = bid * NWAVES + wave, NGW = G * NWAVES;
    f32x4 g[4];
#pragma unroll
    for (int j = 0; j < 4; ++j) g[j] = ((const f32x4*)fn)[lane + 64 * j];
    const bf16_t* xb = (const bf16_t*)(p.ws + WS_XB);
    for (int row = gw * 2; row < MREAL; row += NGW * 2) {
        const float rs0 = pg8::rstd_of(ss[row]), rs1 = pg8::rstd_of(ss[row + 1]);
        f32x4* o = (f32x4*)(p.out + (size_t)row * DM);
        const u32x2* hsrc = (const u32x2*)(xb + (size_t)row * DM);
        u32x2 v0[4], v1[4];
#pragma unroll
        for (int j = 0; j < 4; ++j) { v0[j] = hsrc[lane + 64 * j]; v1[j] = hsrc[256 + lane + 64 * j]; }
#pragma unroll
        for (int j = 0; j < 4; ++j) { __builtin_nontemporal_store(unpk4(v0[j]) * rs0 * g[j], o + lane + 64 * j); __builtin_nontemporal_store(unpk4(v1[j]) * rs1 * g[j], o + 256 + lane + 64 * j); }
    }
}

#define XB_TMO      128
#define XB_XCNT(j)  (256  + 64 * (j))
#define XB_XSUB(j)  (1280 + 64 * (j))
#define XB_XGEN(j)  (2304 + 64 * (j))
#define XB_TOP      3328
#define XB_TOPGEN   3392
#define XCD_BAR_WORDS 3456
#define XB_SPIN_CAP (1u << 18)

__device__ __forceinline__ unsigned xb_ld(unsigned* p)              { return __hip_atomic_load(p, __ATOMIC_RELAXED, __HIP_MEMORY_SCOPE_AGENT); }
__device__ __forceinline__ unsigned xb_add(unsigned* p, unsigned v) { return __hip_atomic_fetch_add(p, v, __ATOMIC_RELAXED, __HIP_MEMORY_SCOPE_AGENT); }
__device__ __forceinline__ unsigned xb_xcc_id() { return (unsigned)__builtin_amdgcn_s_getreg((3 << 11) | 20) & 0xFu; }
#define XB_SPIN(cond, bar) do { unsigned _sp = 0; while (cond) { __builtin_amdgcn_s_sleep(1); \
    if ((++_sp & 255u) == 0u) { if (xb_ld(&(bar)[XB_TMO])) break; if (_sp > XB_SPIN_CAP) { atomicAdd(&(bar)[XB_TMO], 1u); break; } } } } while (0)

struct XcdBarrier {
    unsigned* bar; unsigned x;
    volatile LAS unsigned* st;
};

__device__ __forceinline__ XcdBarrier xcd_barrier_post(unsigned* bar, volatile LAS unsigned* st) {
    XcdBarrier b; b.bar = bar; b.x = xb_xcc_id(); b.st = st;
    if (threadIdx.x == 0) (void)xb_add(&bar[XB_XCNT(b.x)], 1u);
    return b;
}
__device__ __forceinline__ void xcd_barrier_complete(unsigned* bar, unsigned x, unsigned& nloc, unsigned& nx) {
    const unsigned G = gridDim.x * gridDim.y * gridDim.z;
    unsigned sum, cnt, mine, sp = 0u;
    for (;;) {
        sum = 0u; cnt = 0u; mine = 0u;
#pragma unroll
        for (unsigned j = 0; j < 16; ++j) { const unsigned c = xb_ld(&bar[XB_XCNT(j)]); sum += c; cnt += (c > 0u) ? 1u : 0u; mine = (j == x) ? c : mine; }
        if (sum == G) break;
        __builtin_amdgcn_s_sleep(1);
        if ((++sp & 255u) == 0u) { if (xb_ld(&bar[XB_TMO])) break; if (sp > XB_SPIN_CAP) { atomicAdd(&bar[XB_TMO], 1u); break; } }
    }
    nloc = mine > 0u ? mine : 1u; nx = cnt > 0u ? cnt : 1u;
}

__device__ __forceinline__ void xcd_barrier(const XcdBarrier& b) {
    asm volatile("s_waitcnt vmcnt(0)" ::: "memory");
    __syncthreads();
    if (threadIdx.x == 0) {
        unsigned* bar = b.bar;
        __builtin_amdgcn_s_waitcnt(0);
        unsigned nloc = b.st[0], nx = b.st[1];
        if (nloc == 0u) { xcd_barrier_complete(bar, b.x, nloc, nx); b.st[0] = nloc; b.st[1] = nx; }
        const unsigned old = xb_add(&bar[XB_XSUB(b.x)], 1u);
        const unsigned gen = old / nloc;
        if (old + 1u == (gen + 1u) * nloc) {
            __builtin_amdgcn_fence(__ATOMIC_RELEASE, "agent");
            asm volatile("s_waitcnt vmcnt(0)" ::: "memory");
            const unsigned og = xb_add(&bar[XB_TOP], 1u);
            const unsigned tg = og / nx;
            if (og + 1u == (tg + 1u) * nx) xb_add(&bar[XB_TOPGEN], 1u);
            else XB_SPIN(xb_ld(&bar[XB_TOPGEN]) == tg, bar);
            __builtin_amdgcn_fence(__ATOMIC_ACQUIRE, "agent");
            xb_add(&bar[XB_XGEN(b.x)], 1u);
            asm volatile("s_waitcnt vmcnt(0)" ::: "memory");
        } else {
            XB_SPIN(xb_ld(&bar[XB_XGEN(b.x)]) == gen, bar);
            __builtin_amdgcn_fence(__ATOMIC_ACQUIRE, "agent");
            asm volatile("s_waitcnt vmcnt(0)" ::: "memory");
        }
    }
    __syncthreads();
}

__global__ void __launch_bounds__(NTHREADS, 2) hymba_fwd(Params p) {
    extern __shared__ __attribute__((aligned(16))) unsigned char lds_raw[];
    LAS unsigned char* lds = (LAS unsigned char*)lds_raw;
    cg::grid_group grid = cg::this_grid();
    const int tid0 = threadIdx.x, bid = blockIdx.x, G = gridDim.x;
#define OPQ_TID() ({ int t_ = tid0; asm volatile("" : "+v"(t_)); t_; })
    const int tid = tid0;
    unsigned char* ws = p.ws;
    float* ss = (float*)(ws + WS_SS);
    bf16_t* xb = (bf16_t*)(ws + WS_XB); bf16_t* act = (bf16_t*)(ws + WS_ACT); bf16_t* mix = (bf16_t*)(ws + WS_MIX);


    volatile LAS unsigned* xst = (volatile LAS unsigned*)(lds + 131072 + 64);
    if (tid == 0) { xst[0] = 0u; xst[1] = 0u; }
    __syncthreads();
    const XcdBarrier xbar = xcd_barrier_post((unsigned*)(ws + WS_BAR), xst);
    phase_prologue(p, lds, G, bid, OPQ_TID());
    if (G == 0x7fffffff) grid.sync();
    xcd_barrier(xbar);
    {
        meta_gemm<1>(p, lds, G, bid, OPQ_TID());
        pg8::Gemm g{xb, (const bf16_t*)(ws + WS_WGU1), MREAL, NGU, DM}; pg8::StaticOrder S; S.init(MREAL, NGU, G, bid);
        pg8::EpiSwiglu E{ss, act};
        pg8::gemm_phase<pg8::EpiSwiglu, pg8::StaticOrder, true, true>(lds, g, S, E);
    }
    xcd_barrier(xbar);
    {
        meta_gemm<2>(p, lds, G, bid, OPQ_TID());
        pg8::Gemm g{act, (const bf16_t*)(ws + WS_WD1), MREAL, DM, DFF}; pg8::StaticOrder S; S.init(MREAL, DM, G, bid);
        pg8::EpiResid<1> E{nullptr, nullptr, xb, ss + MPAD, 0.5f};
        pg8::gemm_phase<pg8::EpiResid<1>, pg8::StaticOrder, true, true>(lds, g, S, E);
    }
    xcd_barrier(xbar);
    {
        meta_gemm<3>(p, lds, G, bid, OPQ_TID());
        pg8::Gemm g{xb, (const bf16_t*)(ws + WS_WIN), MREAL, NINP, DM}; pg8::StaticOrder S; S.init(MREAL, NINP, G, bid);
        pg8::EpiProj E{ss + MPAD, mix, (bf16_t*)(ws + WS_KB), (bf16_t*)(ws + WS_VT), (bf16_t*)(ws + WS_PB)};
        pg8::gemm_phase<pg8::EpiProj, pg8::StaticOrder, true, true>(lds, g, S, E);
    }
    xcd_barrier(xbar);
    {
        const int tq = OPQ_TID(), lane = tq & 63, wave = tq >> 6, gw = bid * NWAVES + wave, NGW = G * NWAVES;
        for (int it = gw; it < MREAL / 4; it += NGW) rp_item(p, it >> 2, (it & 3) * 8, 8, lane);
        if (gw < 32) rp_item(p, MREAL / 16, gw, 1, lane);
    }
    xcd_barrier(xbar);
    phase_scan(p, lds, G, bid, OPQ_TID());
    xcd_barrier(xbar);
    phase_post(p, G, bid, OPQ_TID());
    xcd_barrier(xbar);
    {
        pg8::Gemm g{mix, (const bf16_t*)(ws + WS_WOUT), MREAL, DM, DM}; pg8::StaticOrder S; S.init(MREAL, DM, G, bid);
        pg8::EpiResid<1> E{nullptr, nullptr, xb, ss + 2 * MPAD, 1.0f};
        pg8::gemm_phase<pg8::EpiResid<1>, pg8::StaticOrder, true, true>(lds, g, S, E);
    }
    xcd_barrier(xbar);
    {
        pg8::Gemm g{xb, (const bf16_t*)(ws + WS_WGU2), MREAL, NGU, DM}; pg8::StaticOrder S; S.init(MREAL, NGU, G, bid);
        pg8::EpiSwiglu E{ss + 2 * MPAD, act};
        pg8::gemm_phase<pg8::EpiSwiglu, pg8::StaticOrder, true, true>(lds, g, S, E);
    }
    xcd_barrier(xbar);
    {
        pg8::Gemm g{act, (const bf16_t*)(ws + WS_WD2), MREAL, DM, DFF}; pg8::StaticOrder S; S.init(MREAL, DM, G, bid);
        pg8::EpiResid<2> E{nullptr, p.out, xb, ss + 3 * MPAD, 0.5f};
        pg8::gemm_phase<pg8::EpiResid<2>, pg8::StaticOrder, true, true>(lds, g, S, E);
    }
    xcd_barrier(xbar);
    phase_final(p, G, bid, OPQ_TID());
}

extern "C" void kernel_launch(void* const* d_in, const int* in_sizes, int n_in, void* d_out, int out_size, void* d_ws, size_t ws_size, hipStream_t stream) {
    static int grid = 0;
    if (grid == 0) {
        if (n_in != 25 || ws_size < WS_END) { fprintf(stderr, "kernel_launch: unexpected inputs (n_in %d, ws %zu, need %zu)\n", n_in, ws_size, (size_t)WS_END); grid = -1; return; }
        int dev = 0, cus = 0, per_cu = 0;
        (void)hipGetDevice(&dev);
        (void)hipDeviceGetAttribute(&cus, hipDeviceAttributeMultiprocessorCount, dev);
        (void)hipFuncSetAttribute((const void*)hymba_fwd, hipFuncAttributeMaxDynamicSharedMemorySize, LDS_BYTES);
        (void)hipOccupancyMaxActiveBlocksPerMultiprocessor(&per_cu, (const void*)hymba_fwd, NTHREADS, LDS_BYTES);
        if (per_cu < 1) { fprintf(stderr, "kernel_launch: occupancy query says %d blocks per CU\n", per_cu); per_cu = 1; }
        (void)hipGetLastError();
        grid = cus * per_cu;
    }
    if (grid < 0) return;
    (void)hipMemsetAsync((unsigned char*)d_ws + WS_BAR, 0, XCD_BAR_WORDS * 4, stream);
    Params p{};
    for (int i = 0; i < 25; ++i) p.in[i] = (const float*)d_in[i];
    p.out = (float*)d_out; p.ws = (unsigned char*)d_ws;
    void* args[] = {&p};
    hipError_t e = hipLaunchCooperativeKernel((const void*)hymba_fwd, dim3(grid), dim3(NTHREADS), args, LDS_BYTES, stream);
    if (e != hipSuccess) fprintf(stderr, "cooperative launch failed: %s (grid %d)\n", hipGetErrorString(e), grid);
}
```
